# Optimizing an MI355X kernel written in HIP

```python
import math
import jax, jax.numpy as jnp
from jax import lax
import numpy as np

D_MODEL = 2048
BATCH = 1
SEQ = 8192
DEPTH = 1

PLE_DIM = 256
MLA_HEADS = 8
Q_LORA = 512
KV_LORA = 512
QK_NOPE = 128
QK_ROPE = 64
V_HEAD = 128
ROPE_THETA = 10000.0
SWA_HEADS = 16
SWA_KV_HEADS = 2
SWA_HEAD_DIM = 64
WINDOW = 128
BLOCK = 128
REL_BUCKETS = 32
REL_MAX_DIST = 128
D_FF = 5632
ALPHA = (2.0 * DEPTH) ** 0.25
BETA = (8.0 * DEPTH) ** -0.25
EPS = 1e-5

MLA_WIDTH = MLA_HEADS * V_HEAD
SWA_WIDTH = SWA_HEADS * SWA_HEAD_DIM
MIX_WIDTH = MLA_WIDTH + SWA_WIDTH
SWA_KV_WIDTH = SWA_KV_HEADS * SWA_HEAD_DIM
IN_SIZES = (Q_LORA, KV_LORA, QK_ROPE, SWA_WIDTH, SWA_KV_WIDTH, SWA_KV_WIDTH)
D_IN = sum(IN_SIZES)

kernel_name = "hybrid_mla_swa_macaron_deepnorm"


def layer_norm(x, g, b):
    xf = x.astype(jnp.float32)
    mu = jnp.mean(xf, axis=-1, keepdims=True)
    xc = xf - mu
    var = jnp.mean(xc * xc, axis=-1, keepdims=True)
    return (xc * lax.rsqrt(var + EPS) * g.astype(jnp.float32) + b.astype(jnp.float32)).astype(x.dtype)


def rms_norm(x, g):
    xf = x.astype(jnp.float32)
    ms = jnp.mean(xf * xf, axis=-1, keepdims=True)
    return (xf * lax.rsqrt(ms + EPS) * g.astype(jnp.float32)).astype(x.dtype)


def swiglu(x, w1, w3, w2):
    return (jax.nn.silu(x @ w1) * (x @ w3)) @ w2


def rope_tables(positions, dim):
    freqs = ROPE_THETA ** (-jnp.arange(0, dim, 2, dtype=jnp.float32) / dim)
    ang = positions.astype(jnp.float32)[..., None] * freqs
    return jnp.cos(ang), jnp.sin(ang)


def apply_rope(x, cos, sin):
    half = x.shape[-1] // 2
    x1, x2 = x[..., :half], x[..., half:]
    c, s = cos.astype(x.dtype), sin.astype(x.dtype)
    return jnp.concatenate([x1 * c - x2 * s, x1 * s + x2 * c], axis=-1)


def t5_bucket(dist):
    n = jnp.maximum(dist, 0)
    max_exact = REL_BUCKETS // 2
    large = max_exact + (jnp.log(jnp.maximum(n, 1).astype(jnp.float32) / max_exact)
                         / math.log(REL_MAX_DIST / max_exact)
                         * (REL_BUCKETS - max_exact)).astype(jnp.int32)
    large = jnp.minimum(large, REL_BUCKETS - 1)
    return jnp.where(n < max_exact, n, large)


def mla_attention(c_q, c_kv, k_rope_raw, cos, sin, q_norm_g, w_uq, kv_norm_g, w_ukv):
    B, S, _ = c_q.shape
    H = MLA_HEADS
    q = (rms_norm(c_q, q_norm_g) @ w_uq).reshape(B, S, H, QK_NOPE + QK_ROPE)
    q_nope = q[..., :QK_NOPE]
    q_rope = apply_rope(q[..., QK_NOPE:], cos[:, :, None, :], sin[:, :, None, :])
    kv = (rms_norm(c_kv, kv_norm_g) @ w_ukv).reshape(B, S, H, QK_NOPE + V_HEAD)
    k_nope, v = kv[..., :QK_NOPE], kv[..., QK_NOPE:]
    k_rope = apply_rope(k_rope_raw, cos, sin)
    scale = (QK_NOPE + QK_ROPE) ** -0.5
    nb = S // BLOCK
    qn_blk = q_nope.reshape(B, nb, BLOCK, H, QK_NOPE).transpose(1, 0, 2, 3, 4)
    qr_blk = q_rope.reshape(B, nb, BLOCK, H, QK_ROPE).transpose(1, 0, 2, 3, 4)
    key_pos = jnp.arange(S)
    neg = jnp.finfo(jnp.float32).min

    def one_block(args):
        qn, qr, blk = args
        s = (jnp.einsum('bqhd,bkhd->bhqk', qn, k_nope)
             + jnp.einsum('bqhd,bkd->bhqk', qr, k_rope)).astype(jnp.float32) * scale
        q_pos = blk * BLOCK + jnp.arange(BLOCK)
        s = jnp.where(key_pos[None, :] <= q_pos[:, None], s, neg)
        pr = jax.nn.softmax(s, axis=-1)
        return jnp.einsum('bhqk,bkhd->bqhd', pr.astype(v.dtype), v)

    out = lax.map(one_block, (qn_blk, qr_blk, jnp.arange(nb)))
    return out.transpose(1, 0, 2, 3, 4).reshape(B, S, MLA_WIDTH)


def swa_attention(q, k, v, sinks, rel_bias):
    B, S, _ = q.shape
    nb = S // BLOCK
    KV, G, Dh = SWA_KV_HEADS, SWA_HEADS // SWA_KV_HEADS, SWA_HEAD_DIM
    q = q.reshape(B, nb, BLOCK, KV, G, Dh)
    k = k.reshape(B, nb, BLOCK, KV, Dh)
    v = v.reshape(B, nb, BLOCK, KV, Dh)
    k_prev = jnp.concatenate([jnp.zeros_like(k[:, :1]), k[:, :-1]], axis=1)
    v_prev = jnp.concatenate([jnp.zeros_like(v[:, :1]), v[:, :-1]], axis=1)
    k_band = jnp.concatenate([k_prev, k], axis=2)
    v_band = jnp.concatenate([v_prev, v], axis=2)
    s = jnp.einsum('bnqkgd,bnjkd->bkgnqj', q, k_band).astype(jnp.float32) * (Dh ** -0.5)
    qi = jnp.arange(BLOCK)[:, None] + BLOCK
    kj = jnp.arange(2 * BLOCK)[None, :]
    dist = qi - kj
    bias = rel_bias[t5_bucket(dist)].astype(jnp.float32)
    s = s + bias.transpose(2, 0, 1).reshape(KV, G, 1, BLOCK, 2 * BLOCK)
    valid = (dist >= 0) & (dist < WINDOW)
    blk = jnp.arange(nb)[:, None, None]
    valid = valid[None] & ((blk > 0) | (kj[None] >= BLOCK))
    s = jnp.where(valid, s, jnp.finfo(jnp.float32).min)
    sink = sinks.astype(jnp.float32).reshape(KV, G, 1, 1, 1)
    m = jnp.maximum(jnp.max(s, axis=-1, keepdims=True), sink)
    e = jnp.exp(s - m)
    pr = e / (jnp.sum(e, axis=-1, keepdims=True) + jnp.exp(sink - m))
    out = jnp.einsum('bkgnqj,bnjkd->bnqkgd', pr.astype(v.dtype), v_band)
    return out.reshape(B, S, SWA_WIDTH)


def setup_inputs(seed: int = 0) -> dict:
    key = jax.random.key(seed)
    ks = jax.random.split(key, 32)
    f32 = jnp.float32
    L, D = DEPTH, D_MODEL

    def nrm(k, shape, scale):
        return jax.random.normal(k, shape, f32) * scale

    def gain(k, shape):
        return 1.0 + 0.02 * jax.random.normal(k, shape, f32)

    return {
        "x": nrm(ks[0], (BATCH, SEQ, D), 1.0),
        "p": nrm(ks[1], (DEPTH, BATCH, SEQ, PLE_DIM), 1.0),
        "positions": jnp.broadcast_to(jnp.arange(SEQ, dtype=jnp.int32), (BATCH, SEQ)),
        "rel_bias": nrm(ks[2], (REL_BUCKETS, SWA_HEADS), 0.5),
        "ln1_g": gain(ks[3], (L, D)),
        "ln1_b": nrm(ks[4], (L, D), 0.02),
        "ffn1_w1": nrm(ks[5], (L, D, D_FF), D ** -0.5),
        "ffn1_w3": nrm(ks[6], (L, D, D_FF), D ** -0.5),
        "ffn1_w2": nrm(ks[7], (L, D_FF, D), D_FF ** -0.5 * BETA),
        "w_in": nrm(ks[8], (L, D, D_IN), D ** -0.5),
        "q_norm_g": gain(ks[9], (L, Q_LORA)),
        "w_uq": nrm(ks[10], (L, Q_LORA, MLA_HEADS * (QK_NOPE + QK_ROPE)), Q_LORA ** -0.5),
        "kv_norm_g": gain(ks[11], (L, KV_LORA)),
        "w_ukv": nrm(ks[12], (L, KV_LORA, MLA_HEADS * (QK_NOPE + V_HEAD)), KV_LORA ** -0.5),
        "swa_sinks": nrm(ks[13], (L, SWA_HEADS), 0.5),
        "mla_out_g": gain(ks[14], (L, MLA_WIDTH)),
        "swa_out_g": gain(ks[15], (L, SWA_WIDTH)),
        "w_out": nrm(ks[16], (L, MIX_WIDTH, D), MIX_WIDTH ** -0.5 * BETA),
        "ln2_g": gain(ks[17], (L, D)),
        "ln2_b": nrm(ks[18], (L, D), 0.02),
        "ffn2_w1": nrm(ks[19], (L, D, D_FF), D ** -0.5),
        "ffn2_w3": nrm(ks[20], (L, D, D_FF), D ** -0.5),
        "ffn2_w2": nrm(ks[21], (L, D_FF, D), D_FF ** -0.5 * BETA),
        "ln3_g": gain(ks[22], (L, D)),
        "ln3_b": nrm(ks[23], (L, D), 0.02),
        "ple_w_gate": nrm(ks[24], (L, D, D), D ** -0.5),
        "ple_w_proj": nrm(ks[25], (L, PLE_DIM, D), PLE_DIM ** -0.5 * BETA),
    }


def reference(x, p, positions, rel_bias, ln1_g, ln1_b, ffn1_w1, ffn1_w3, ffn1_w2,
              w_in, q_norm_g, w_uq, kv_norm_g, w_ukv, swa_sinks, mla_out_g, swa_out_g,
              w_out, ln2_g, ln2_b, ffn2_w1, ffn2_w3, ffn2_w2, ln3_g, ln3_b,
              ple_w_gate, ple_w_proj):
    cos, sin = rope_tables(positions, QK_ROPE)
    bounds = list(np.cumsum(IN_SIZES)[:-1])
    h = x
    for i in range(DEPTH):
        h = layer_norm(ALPHA * h + 0.5 * swiglu(h, ffn1_w1[i], ffn1_w3[i], ffn1_w2[i]), ln1_g[i], ln1_b[i])
        z = h @ w_in[i]
        c_q, c_kv, k_rope_raw, q_s, k_s, v_s = jnp.split(z, bounds, axis=-1)
        a_mla = mla_attention(c_q, c_kv, k_rope_raw, cos, sin,
                              q_norm_g[i], w_uq[i], kv_norm_g[i], w_ukv[i])
        a_swa = swa_attention(q_s, k_s, v_s, swa_sinks[i], rel_bias)
        mixed = jnp.concatenate([rms_norm(a_mla, mla_out_g[i]), rms_norm(a_swa, swa_out_g[i])], axis=-1)
        h = layer_norm(ALPHA * h + mixed @ w_out[i], ln2_g[i], ln2_b[i])
        h = layer_norm(ALPHA * h + 0.5 * swiglu(h, ffn2_w1[i], ffn2_w3[i], ffn2_w2[i]), ln3_g[i], ln3_b[i])
        h = h + jax.nn.sigmoid(h @ ple_w_gate[i]) * (p[i] @ ple_w_proj[i])
    return h
```

```cpp
#include <hip/hip_runtime.h>
#include <cstdio>
#include <cstdint>

#define LAS __attribute__((address_space(3)))
#define GAS __attribute__((address_space(1)))
typedef unsigned short bf16_t;
typedef short bf16x8 __attribute__((ext_vector_type(8)));
typedef float f32x4 __attribute__((ext_vector_type(4)));
typedef float f32x2 __attribute__((ext_vector_type(2)));
typedef unsigned u32x4 __attribute__((ext_vector_type(4)));
typedef unsigned u32x2 __attribute__((ext_vector_type(2)));
typedef GAS unsigned gu32;

constexpr int M = 8192, D = 2048, FF = 5632, PLE = 256, DIN = 2368;
constexpr int ZLD = 2560;
constexpr int NH = 8, NOPE = 128, ROPE = 64, QKD = 192, VD = 128, QLORA = 512, KVLORA = 512;
constexpr int QLD = NH * QKD;
constexpr int KLD = NH * NOPE;
constexpr int SWH = 16, SWKV = 2, SWD = 64, WINDOW = 128;
constexpr float ALPHA = 1.189207115002721f, LN_EPS = 1e-5f;
constexpr float LOG2E = 1.4426950408889634f;
constexpr float MLA_QSCALE = 0.10411754627697264f;
constexpr float SWA_SCALE2 = 0.18033688011112042f;
constexpr int Z_CQ = 0, Z_CKV = 512, Z_QS = 1024, Z_KS = 2048, Z_VS = 2176;

constexpr size_t MiB = 1u << 20;
constexpr size_t WS_CTL = 0, CTL_ZERO_BYTES = 1 * MiB;
constexpr size_t WS_COS = 1 * MiB, WS_SIN = 2 * MiB;
constexpr size_t WS_BIAS = 3 * MiB;
constexpr size_t WS_SSQ = 3 * MiB + 65536;
constexpr size_t WS_W13A = 4 * MiB;
constexpr size_t WS_W2A = WS_W13A + 44 * MiB;
constexpr size_t WS_W13B = WS_W2A + 22 * MiB;
constexpr size_t WS_W2B = WS_W13B + 44 * MiB;
constexpr size_t WS_WIN = WS_W2B + 22 * MiB;
constexpr size_t WS_WUQ = WS_WIN + 10 * MiB;
constexpr size_t WS_WUKV = WS_WUQ + 2 * MiB;
constexpr size_t WS_WOUT = WS_WUKV + 2 * MiB;
constexpr size_t WS_WG = WS_WOUT + 8 * MiB;
constexpr size_t WS_WPLE = WS_WG + 8 * MiB;
constexpr size_t WS_HB = WS_WPLE + 1 * MiB;
constexpr size_t WS_PB = WS_HB + 32 * MiB;
constexpr size_t WS_PL = WS_PB + 4 * MiB;
constexpr size_t WS_R = WS_PL + 32 * MiB;
constexpr size_t WS_G = WS_R;
constexpr size_t WS_Z = WS_R;
constexpr size_t WS_Q = WS_Z + 40 * MiB;
constexpr size_t WS_K = WS_Q + 24 * MiB;
constexpr size_t WS_V = WS_K + 16 * MiB;
constexpr size_t WS_KR = WS_V + 16 * MiB;
constexpr size_t WS_AMIX = WS_KR + 1 * MiB;
constexpr size_t WS_END = WS_AMIX + 32 * MiB;
static_assert(WS_G + (size_t)M * FF * 2 <= WS_END, "G overlay fits");
constexpr int CW_BAR = 4096;

__device__ __forceinline__ float bf2f(bf16_t b) { return __uint_as_float((unsigned)b << 16); }
__device__ __forceinline__ unsigned f2bf(float f) { unsigned u = __float_as_uint(f); return (u + 0x7fffu + ((u >> 16) & 1u)) >> 16; }
__device__ __forceinline__ unsigned pk2(float lo, float hi) { return f2bf(lo) | (f2bf(hi) << 16); }
__device__ __forceinline__ float wave_sum(float v) {
#pragma unroll
    for (int o = 1; o < 64; o <<= 1) v += __shfl_xor(v, o);
    return v;
}
__device__ __forceinline__ float wave_max(float v) {
#pragma unroll
    for (int o = 1; o < 64; o <<= 1) v = fmaxf(v, __shfl_xor(v, o));
    return v;
}
namespace pg8 {
#define PG8_LAS __attribute__((address_space(3)))
constexpr int BM = 256, BK = 64, HALF = 128, HTB = HALF * BK * 2  , STAGE_BYTES = 8 * HTB, NXCD = 8, WGM = 8;

__host__ __device__ __forceinline__ int lds_byte(int r, int c) { const int st = (r >> 4) * 2 + (c >> 5), rr = r & 15, cc = c & 31, ob = rr * 64 + cc * 2; return st * 1024 + (ob ^ (((ob >> 9) & 1) << 5)); }
__host__ __device__ __forceinline__ void stage_rc(int b, int& R, int& C) { const int st = b / 1024, sb = b % 1024, swz = sb ^ (((sb >> 9) & 1) << 5); R = (st >> 1) * 16 + swz / 64; C = (st & 1) * 32 + (swz % 64) / 2; }
__host__ __device__ __forceinline__ int perm32(int rho) { const int n = rho >> 4, i = rho & 15; return 8 * (i >> 2) + 4 * n + (i & 3); }

struct Unit { int pm, pn; };
struct Gemm { const bf16_t* A; const bf16_t* Bt; int M, N, K, lda, ldb; };

struct StaticOrder {
    int nM, nN, nwg, G, c;
    __host__ __device__ void init(int M_, int N_, int G_, int c_) { nM = M_ / BM; nN = N_ / BM; nwg = nM * nN; G = G_; c = c_; }
    __host__ __device__ bool next(int i, Unit& u) const {
        const long L = (long)i * G + c; if (L >= nwg) return false;
        int wgid = (int)L; { const int q = nwg / NXCD, r = nwg % NXCD, xcd = wgid % NXCD, off = wgid / NXCD; wgid = (xcd < r ? xcd * (q + 1) : r * (q + 1) + (xcd - r) * q) + off; }
        const int nig = WGM * nN, gid = wgid / nig, fm = gid * WGM, gsz = (nM - fm) < WGM ? (nM - fm) : WGM;
        u.pm = fm + ((wgid % nig) % gsz); u.pn = (wgid % nig) / gsz; return true;
    }
    __device__ __forceinline__ void a_ready(const Unit&) const {}
    __device__ __forceinline__ void done(const Unit&) const {}
};

typedef __bf16 bf16x2_t __attribute__((ext_vector_type(2)));
__device__ __forceinline__ unsigned cvt_pk_bf16(float lo, float hi) { const f32x2 v = {lo, hi}; const bf16x2_t b = __builtin_convertvector(v, bf16x2_t); return __builtin_bit_cast(unsigned, b); }
__device__ __forceinline__ u32x4 pack8(const f32x4 v0, const f32x4 v1) { u32x4 w; w.x = cvt_pk_bf16(v0[0], v0[1]); w.y = cvt_pk_bf16(v0[2], v0[3]); w.z = cvt_pk_bf16(v1[0], v1[1]); w.w = cvt_pk_bf16(v1[2], v1[3]); return w; }
__device__ __forceinline__ float sigmoidf_fast(float v) { return __builtin_amdgcn_rcpf(1.0f + __builtin_amdgcn_exp2f(-v * 1.4426950408889634f)); }

struct EpiBf16 {
    static constexpr bool PERM = true, AFTER_DRAIN = false;
    bf16_t* O; int ldc;
    __device__ __forceinline__ void operator()(const f32x4 (&acc)[2][2][4][2], const Unit& u, int wr, int wc, int fr, int fq) const {
        const int row0 = u.pm * BM + wr * 64 + fr, col0 = u.pn * BM + wc * 32 + 8 * fq;
#pragma unroll
        for (int ai = 0; ai < 2; ++ai)
#pragma unroll
            for (int m = 0; m < 4; ++m) { bf16_t* rowp = O + (size_t)(row0 + ai * HALF + m * 16) * ldc + col0;
#pragma unroll
                for (int bj = 0; bj < 2; ++bj) *(u32x4*)(rowp + bj * HALF) = pack8(acc[ai][bj][m][0], acc[ai][bj][m][1]); }
    }
};
struct EpiSwiGLU {
    static constexpr bool PERM = true, AFTER_DRAIN = false;
    bf16_t* G; int ldc;
    __device__ __forceinline__ void operator()(const f32x4 (&acc)[2][2][4][2], const Unit& u, int wr, int wc, int fr, int fq) const {
        const int row0 = u.pm * BM + wr * 64 + fr, col0 = u.pn * HALF + wc * 32 + 8 * fq;
#pragma unroll
        for (int ai = 0; ai < 2; ++ai)
#pragma unroll
            for (int m = 0; m < 4; ++m) { bf16_t* rowp = G + (size_t)(row0 + ai * HALF + m * 16) * ldc + col0;
                f32x4 g[2];
#pragma unroll
                for (int n = 0; n < 2; ++n)
#pragma unroll
                    for (int e = 0; e < 4; ++e) { const float a = acc[ai][0][m][n][e], b = acc[ai][1][m][n][e]; g[n][e] = a * sigmoidf_fast(a) * b; }
                *(u32x4*)rowp = pack8(g[0], g[1]); }
    }
};
struct EpiResid {
    static constexpr bool PERM = false, AFTER_DRAIN = false;
    const float* res; float* out; int ldc; float alpha, s;
    __device__ __forceinline__ void operator()(const f32x4 (&acc)[2][2][4][2], const Unit& u, int wr, int wc, int fr, int fq) const {
        const int row0 = u.pm * BM + wr * 64 + fr, col0 = u.pn * BM + wc * 32 + 4 * fq;
#pragma unroll
        for (int ai = 0; ai < 2; ++ai)
#pragma unroll
            for (int m = 0; m < 4; ++m) { const size_t off = (size_t)(row0 + ai * HALF + m * 16) * ldc + col0;
#pragma unroll
                for (int bj = 0; bj < 2; ++bj)
#pragma unroll
                    for (int n = 0; n < 2; ++n) { const f32x4 r = *(const f32x4*)(res + off + bj * HALF + n * 16); *(f32x4*)(out + off + bj * HALF + n * 16) = r * alpha + acc[ai][bj][m][n] * s; } }
    }
};
struct EpiGate {
    static constexpr bool PERM = false, AFTER_DRAIN = false;
    float* out; const bf16_t* pl; int ldc;
    __device__ __forceinline__ void operator()(const f32x4 (&acc)[2][2][4][2], const Unit& u, int wr, int wc, int fr, int fq) const {
        const int row0 = u.pm * BM + wr * 64 + fr, col0 = u.pn * BM + wc * 32 + 4 * fq;
#pragma unroll
        for (int ai = 0; ai < 2; ++ai)
#pragma unroll
            for (int m = 0; m < 4; ++m) { const size_t off = (size_t)(row0 + ai * HALF + m * 16) * ldc + col0;
#pragma unroll
                for (int bj = 0; bj < 2; ++bj)
#pragma unroll
                    for (int n = 0; n < 2; ++n) { const size_t o = off + bj * HALF + n * 16; const f32x4 h = *(const f32x4*)(out + o); const u32x2 pw = *(const u32x2*)(pl + o);
                        f32x4 p; p[0] = __uint_as_float(pw.x << 16); p[1] = __uint_as_float(pw.x & 0xffff0000u); p[2] = __uint_as_float(pw.y << 16); p[3] = __uint_as_float(pw.y & 0xffff0000u);
                        f32x4 r;
#pragma unroll
                        for (int e = 0; e < 4; ++e) r[e] = h[e] + sigmoidf_fast(acc[ai][bj][m][n][e]) * p[e];
                        *(f32x4*)(out + o) = r; } }
    }
};
struct EpiZ {
    static constexpr bool PERM = true, AFTER_DRAIN = false;
    bf16_t* Z; float* ssq; bf16_t* KR; const float* cs; const float* sn;
    __device__ __forceinline__ void operator()(const f32x4 (&acc)[2][2][4][2], const Unit& u, int wr, int wc, int fr, int fq) const {
        const int row0 = u.pm * BM + wr * 64 + fr;
        if (u.pn < 9) {
            const int col0 = u.pn * BM + wc * 32 + 8 * fq;
#pragma unroll
            for (int ai = 0; ai < 2; ++ai)
#pragma unroll
                for (int m = 0; m < 4; ++m) { const int row = row0 + ai * HALF + m * 16; bf16_t* rowp = Z + (size_t)row * ZLD + col0;
#pragma unroll
                    for (int bj = 0; bj < 2; ++bj) *(u32x4*)(rowp + bj * HALF) = pack8(acc[ai][bj][m][0], acc[ai][bj][m][1]);
                    if (u.pn < 4) { float s = 0.f;
#pragma unroll
                        for (int bj = 0; bj < 2; ++bj)
#pragma unroll
                            for (int n = 0; n < 2; ++n) { const f32x4 x = acc[ai][bj][m][n]; s += (x[0] * x[0] + x[1] * x[1]) + (x[2] * x[2] + x[3] * x[3]); }
                        s += __shfl_xor(s, 16); s += __shfl_xor(s, 32);
                        if (fq == 0) ssq[(size_t)row * 16 + u.pn * 4 + wc] = s; } }
        } else if (wc == 0) {
#pragma unroll
            for (int ai = 0; ai < 2; ++ai)
#pragma unroll
                for (int m = 0; m < 4; ++m) { const int row = row0 + ai * HALF + m * 16; f32x4 o1[2], o2[2];
#pragma unroll
                    for (int n = 0; n < 2; ++n) { const f32x4 c = *(const f32x4*)(cs + (size_t)row * 32 + 8 * fq + 4 * n), s = *(const f32x4*)(sn + (size_t)row * 32 + 8 * fq + 4 * n);
                        const f32x4 x1 = acc[ai][0][m][n], x2 = acc[ai][1][m][n]; o1[n] = x1 * c - x2 * s; o2[n] = x1 * s + x2 * c; }
                    *(u32x4*)(KR + (size_t)row * 64 + 8 * fq) = pack8(o1[0], o1[1]); *(u32x4*)(KR + (size_t)row * 64 + 32 + 8 * fq) = pack8(o2[0], o2[1]); }
        }
    }
};
struct EpiQ {
    static constexpr bool PERM = true, AFTER_DRAIN = false;
    bf16_t* Q; const float* ssq; const float* cs; const float* sn; float qscale;
    __device__ __forceinline__ void operator()(const f32x4 (&acc)[2][2][4][2], const Unit& u, int wr, int wc, int fr, int fq) const {
        const int row0 = u.pm * BM + wr * 64 + fr;
#pragma unroll
        for (int ai = 0; ai < 2; ++ai)
#pragma unroll
            for (int m = 0; m < 4; ++m) { const int row = row0 + ai * HALF + m * 16;
                const f32x4 p0 = *(const f32x4*)(ssq + (size_t)row * 16), p1 = *(const f32x4*)(ssq + (size_t)row * 16 + 4);
                const float rs = qscale / sqrtf(((p0[0] + p0[1]) + (p0[2] + p0[3]) + (p1[0] + p1[1]) + (p1[2] + p1[3])) * (1.0f / QLORA) + LN_EPS);
                if (u.pn < 4) {
#pragma unroll
                    for (int bj = 0; bj < 2; ++bj) *(u32x4*)(Q + (size_t)row * QLD + (2 * u.pn + bj) * QKD + wc * 32 + 8 * fq) = pack8(acc[ai][bj][m][0] * rs, acc[ai][bj][m][1] * rs);
                } else { const int head = 4 * (u.pn - 4) + wc; f32x4 o1[2], o2[2];
#pragma unroll
                    for (int n = 0; n < 2; ++n) { const f32x4 c = *(const f32x4*)(cs + (size_t)row * 32 + 8 * fq + 4 * n), s = *(const f32x4*)(sn + (size_t)row * 32 + 8 * fq + 4 * n);
                        const f32x4 x1 = acc[ai][0][m][n] * rs, x2 = acc[ai][1][m][n] * rs; o1[n] = x1 * c - x2 * s; o2[n] = x1 * s + x2 * c; }
                    bf16_t* qp = Q + (size_t)row * QLD + head * QKD + NOPE + 8 * fq;
                    *(u32x4*)qp = pack8(o1[0], o1[1]); *(u32x4*)(qp + 32) = pack8(o2[0], o2[1]); } }
    }
};
struct EpiKV {
    static constexpr bool PERM = true, AFTER_DRAIN = false;
    bf16_t* Kb; bf16_t* Vb; const float* ssq;
    __device__ __forceinline__ void operator()(const f32x4 (&acc)[2][2][4][2], const Unit& u, int wr, int wc, int fr, int fq) const {
        const int row0 = u.pm * BM + wr * 64 + fr;
#pragma unroll
        for (int ai = 0; ai < 2; ++ai)
#pragma unroll
            for (int m = 0; m < 4; ++m) { const int row = row0 + ai * HALF + m * 16;
                const f32x4 p0 = *(const f32x4*)(ssq + (size_t)row * 16 + 8), p1 = *(const f32x4*)(ssq + (size_t)row * 16 + 12);
                const float rs = 1.0f / sqrtf(((p0[0] + p0[1]) + (p0[2] + p0[3]) + (p1[0] + p1[1]) + (p1[2] + p1[3])) * (1.0f / KVLORA) + LN_EPS);
                const size_t o = (size_t)row * KLD + u.pn * NOPE + wc * 32 + 8 * fq;
                *(u32x4*)(Kb + o) = pack8(acc[ai][0][m][0] * rs, acc[ai][0][m][1] * rs);
                *(u32x4*)(Vb + o) = pack8(acc[ai][1][m][0] * rs, acc[ai][1][m][1] * rs); }
    }
};

template <class Epi, class Sched>
__device__ __forceinline__ void gemm_ref(const Gemm g, const Sched& S, const Epi& E) {
    const int tid = threadIdx.x, wid = __builtin_amdgcn_readfirstlane(tid >> 6), lane = tid & 63, wr = wid >> 2, wc = wid & 3, fr = lane & 15, fq = lane >> 4;
    Unit u;
    for (int i = 0; S.next(i, u); ++i) {
        f32x4 acc[2][2][4][2];
#pragma unroll
        for (int a = 0; a < 2; ++a)
#pragma unroll
            for (int b = 0; b < 2; ++b)
#pragma unroll
                for (int m = 0; m < 4; ++m)
#pragma unroll
                    for (int n = 0; n < 2; ++n) acc[a][b][m][n] = (f32x4){0.f, 0.f, 0.f, 0.f};
        const bf16_t* Ab = g.A + (size_t)(u.pm * BM + wr * 64 + fr) * g.lda + fq * 8;
        const bf16_t* Bb = g.Bt + (size_t)(u.pn * BM + wc * 32) * g.ldb + fq * 8;
        const int rb0 = Epi::PERM ? perm32(fr) : fr, rb1 = Epi::PERM ? perm32(16 + fr) : 16 + fr;
        for (int k = 0; k < g.K; k += 32) {
            bf16x8 a[2][4], b[2][2];
#pragma unroll
            for (int ai = 0; ai < 2; ++ai)
#pragma unroll
                for (int m = 0; m < 4; ++m) a[ai][m] = *(const bf16x8*)(Ab + (size_t)(ai * HALF + m * 16) * g.lda + k);
#pragma unroll
            for (int bj = 0; bj < 2; ++bj) { b[bj][0] = *(const bf16x8*)(Bb + (size_t)(bj * HALF + rb0) * g.ldb + k); b[bj][1] = *(const bf16x8*)(Bb + (size_t)(bj * HALF + rb1) * g.ldb + k); }
#pragma unroll
            for (int ai = 0; ai < 2; ++ai)
#pragma unroll
                for (int bj = 0; bj < 2; ++bj)
#pragma unroll
                    for (int m = 0; m < 4; ++m)
#pragma unroll
                        for (int n = 0; n < 2; ++n) acc[ai][bj][m][n] = __builtin_amdgcn_mfma_f32_16x16x32_bf16(b[bj][n], a[ai][m], acc[ai][bj][m][n], 0, 0, 0);
        }
        E(acc, u, wr, wc, fr, fq);
    }
}
template <class Epi, class Sched, bool ALIGN_EPI = false, bool SP2 = false>
__device__ __forceinline__ void gemm_phase(PG8_LAS unsigned char* lds, const Gemm g, const Sched& S, const Epi& E) {
    const int tid = threadIdx.x, wid = __builtin_amdgcn_readfirstlane(tid >> 6), lane = tid & 63, wr = wid >> 2, wc = wid & 3, fr = lane & 15, fq = lane >> 4;
    const int K = g.K, nt = K / BK;
    unsigned voffA[2], voffB[2];
#pragma unroll
    for (int i = 0; i < 2; ++i) { int R, C; stage_rc(tid * 16 + i * 8192, R, C); const int Rb = Epi::PERM ? ((R & ~31) + perm32(R & 31)) : R;
        voffA[i] = (unsigned)(R * g.lda + C) * 2u; voffB[i] = (unsigned)(Rb * g.ldb + C) * 2u; }
    const size_t kstep = (size_t)(BK * 2);
    const size_t hstepA = (size_t)HALF * g.lda * 2, hstepB = (size_t)HALF * g.ldb * 2;
    const size_t tstepA = 2 * hstepA, tstepB = 2 * hstepB;
    const unsigned ldsw = (unsigned)wid * 1024u;
    const int aoff = lds_byte(wr * 64 + fr, fq * 8), boff = lds_byte(wc * 32 + fr, fq * 8);
#define PG8_SA(b, h) (((b) * 2 + (h)) * HTB)
#define PG8_SB(b, h) ((4 + (b) * 2 + (h)) * HTB)
#define PG8_STAGE(bufoff, gbase, voff) do { _Pragma("unroll") for (int _i = 0; _i < 2; ++_i) \
        __builtin_amdgcn_global_load_lds((const unsigned*)((const char*)(gbase) + (voff)[_i]), (PG8_LAS unsigned*)(lds + (bufoff) + ldsw + _i * 8192), 16, 0, 0); } while (0)
#define PG8_LDA(dst, b, h) do { _Pragma("unroll") for (int m = 0; m < 4; ++m) _Pragma("unroll") for (int k = 0; k < 2; ++k) dst[m][k] = *(const PG8_LAS bf16x8*)(lds + PG8_SA(b, h) + aoff + m * 2048 + k * 1024); } while (0)
#define PG8_LDB(dst, b, h) do { _Pragma("unroll") for (int n = 0; n < 2; ++n) _Pragma("unroll") for (int k = 0; k < 2; ++k) dst[n][k] = *(const PG8_LAS bf16x8*)(lds + PG8_SB(b, h) + boff + n * 2048 + k * 1024); } while (0)
#define PG8_MMA(ai, bj, At, Bt) do { __builtin_amdgcn_s_setprio(1); _Pragma("unroll") for (int m = 0; m < 4; ++m) _Pragma("unroll") for (int n = 0; n < 2; ++n) _Pragma("unroll") for (int k = 0; k < 2; ++k) \
        acc[ai][bj][m][n] = __builtin_amdgcn_mfma_f32_16x16x32_bf16(Bt[n][k], At[m][k], acc[ai][bj][m][n], 0, 0, 0); __builtin_amdgcn_s_setprio(0); } while (0)
#define PG8_WAIT_V(n) asm volatile("s_waitcnt vmcnt(" #n ")" ::: "memory")
#define PG8_WAIT_L(n) asm volatile("s_waitcnt lgkmcnt(" #n ")" ::: "memory")
#define PG8_BAR __builtin_amdgcn_s_barrier()
#define PG8_SCHED __builtin_amdgcn_sched_barrier(0)
    Unit cur, nxt; int ui = 0;
    if (!S.next(0, cur)) return;
    f32x4 acc[2][2][4][2];
#pragma unroll
    for (int a = 0; a < 2; ++a)
#pragma unroll
        for (int b = 0; b < 2; ++b)
#pragma unroll
            for (int m = 0; m < 4; ++m)
#pragma unroll
                for (int n = 0; n < 2; ++n) acc[a][b][m][n] = (f32x4){0.f, 0.f, 0.f, 0.f};
    bf16x8 At[4][2], B0[2][2], B1[2][2];
    const char* cA = (const char*)g.A + (size_t)cur.pm * tstepA; const char* cB = (const char*)g.Bt + (size_t)cur.pn * tstepB;
    S.a_ready(cur);
    if constexpr (SP2) {
        PG8_STAGE(PG8_SB(0, 0), cB, voffB); PG8_STAGE(PG8_SB(0, 1), cB + hstepB, voffB); PG8_STAGE(PG8_SA(0, 0), cA, voffA); PG8_STAGE(PG8_SA(0, 1), cA + hstepA, voffA);
        if (wr == 1) PG8_BAR;
        PG8_WAIT_V(2); PG8_BAR;
        PG8_STAGE(PG8_SB(1, 0), cB + kstep, voffB); PG8_STAGE(PG8_SA(1, 0), cA + kstep, voffA); PG8_STAGE(PG8_SB(1, 1), cB + hstepB + kstep, voffB);
        PG8_WAIT_V(6); PG8_BAR;
    } else {
        PG8_STAGE(PG8_SB(0, 0), cB, voffB); PG8_STAGE(PG8_SA(0, 0), cA, voffA); PG8_STAGE(PG8_SB(0, 1), cB + hstepB, voffB); PG8_STAGE(PG8_SA(0, 1), cA + hstepA, voffA);
        if (wr == 1) PG8_BAR;
        PG8_WAIT_V(4); PG8_BAR;
        PG8_STAGE(PG8_SB(1, 0), cB + kstep, voffB); PG8_STAGE(PG8_SA(1, 0), cA + kstep, voffA); PG8_STAGE(PG8_SB(1, 1), cB + hstepB + kstep, voffB);
        PG8_WAIT_V(6); PG8_BAR;
    }
    for (;;) {
        const bool has_next = S.next(ui + 1, nxt);
        const char* nA = has_next ? (const char*)g.A + (size_t)nxt.pm * tstepA : cA; const char* nB = has_next ? (const char*)g.Bt + (size_t)nxt.pn * tstepB : cB;
        for (int t = 0; t < nt; t += 2) {
            const bool last = (t == nt - 2);
            const char* a1 = cA + (size_t)(t + 1) * kstep;
            const char* a2 = last ? nA : cA + (size_t)(t + 2) * kstep; const char* b2 = last ? nB : cB + (size_t)(t + 2) * kstep;
            const char* a3 = a2 + kstep; const char* b3 = b2 + kstep;
            if (last && has_next) S.a_ready(nxt);
            if constexpr (SP2) {
            PG8_LDB(B0, 0, 0); PG8_LDB(B1, 0, 1); PG8_SCHED; PG8_LDA(At, 0, 0); PG8_STAGE(PG8_SA(1, 1), a1 + hstepA, voffA);
            PG8_WAIT_V(8); PG8_WAIT_L(0); PG8_BAR; PG8_MMA(0, 0, At, B0); PG8_MMA(0, 1, At, B1); PG8_BAR; PG8_SCHED;
            PG8_LDA(At, 0, 1); PG8_STAGE(PG8_SB(0, 0), b2, voffB); PG8_STAGE(PG8_SB(0, 1), b2 + hstepB, voffB); PG8_STAGE(PG8_SA(0, 0), a2, voffA);
            PG8_WAIT_V(8); PG8_WAIT_L(0); PG8_BAR; PG8_MMA(1, 0, At, B0); PG8_MMA(1, 1, At, B1); PG8_BAR; PG8_SCHED;
            PG8_LDB(B0, 1, 0); PG8_LDB(B1, 1, 1); PG8_SCHED; PG8_LDA(At, 1, 0); PG8_STAGE(PG8_SA(0, 1), a2 + hstepA, voffA);
            PG8_WAIT_V(8); PG8_WAIT_L(0); PG8_BAR; PG8_MMA(0, 0, At, B0); PG8_MMA(0, 1, At, B1); PG8_BAR; PG8_SCHED;
            PG8_LDA(At, 1, 1); PG8_STAGE(PG8_SB(1, 0), b3, voffB); PG8_STAGE(PG8_SB(1, 1), b3 + hstepB, voffB); PG8_STAGE(PG8_SA(1, 0), a3, voffA);
            PG8_WAIT_V(8); PG8_WAIT_L(0); PG8_BAR; PG8_MMA(1, 0, At, B0); PG8_MMA(1, 1, At, B1); PG8_BAR; PG8_SCHED;
            } else {
            PG8_LDB(B0, 0, 0); PG8_SCHED; PG8_LDA(At, 0, 0); PG8_STAGE(PG8_SA(1, 1), a1 + hstepA, voffA);
            PG8_WAIT_L(8); PG8_BAR; PG8_WAIT_L(0); PG8_MMA(0, 0, At, B0); PG8_BAR; PG8_SCHED;
            PG8_LDB(B1, 0, 1); PG8_STAGE(PG8_SB(0, 0), b2, voffB);
            PG8_BAR; PG8_WAIT_L(0); PG8_MMA(0, 1, At, B1); PG8_BAR;
            PG8_LDA(At, 0, 1); PG8_STAGE(PG8_SA(0, 0), a2, voffA);
            PG8_BAR; PG8_WAIT_L(0); PG8_MMA(1, 0, At, B0); PG8_BAR; PG8_SCHED;
            PG8_STAGE(PG8_SB(0, 1), b2 + hstepB, voffB);
            PG8_WAIT_V(6); PG8_BAR; PG8_MMA(1, 1, At, B1); PG8_BAR;
            PG8_LDB(B0, 1, 0); PG8_SCHED; PG8_LDA(At, 1, 0); PG8_STAGE(PG8_SA(0, 1), a2 + hstepA, voffA);
            PG8_WAIT_L(8); PG8_BAR; PG8_WAIT_L(0); PG8_MMA(0, 0, At, B0); PG8_BAR; PG8_SCHED;
            PG8_LDB(B1, 1, 1); PG8_STAGE(PG8_SB(1, 0), b3, voffB);
            PG8_BAR; PG8_WAIT_L(0); PG8_MMA(0, 1, At, B1); PG8_BAR;
            PG8_LDA(At, 1, 1); PG8_STAGE(PG8_SA(1, 0), a3, voffA);
            PG8_BAR; PG8_WAIT_L(0); PG8_MMA(1, 0, At, B0); PG8_BAR; PG8_SCHED;
            PG8_STAGE(PG8_SB(1, 1), b3 + hstepB, voffB);
            PG8_WAIT_V(6); PG8_BAR; PG8_MMA(1, 1, At, B1); PG8_BAR;
            }
        }
        if constexpr (ALIGN_EPI) { if (wr == 0) PG8_BAR; }
        if constexpr (!Epi::AFTER_DRAIN) { E(acc, cur, wr, wc, fr, fq); S.done(cur); }
        if (!has_next) break;
#pragma unroll
        for (int a = 0; a < 2; ++a)
#pragma unroll
            for (int b = 0; b < 2; ++b)
#pragma unroll
                for (int m = 0; m < 4; ++m)
#pragma unroll
                    for (int n = 0; n < 2; ++n) acc[a][b][m][n] = (f32x4){0.f, 0.f, 0.f, 0.f};
        cur = nxt; cA = nA; cB = nB; ++ui;
        if constexpr (ALIGN_EPI) { if (wr == 1) PG8_BAR; }
    }
    PG8_WAIT_V(0);
    if constexpr (!ALIGN_EPI) { if (wr == 0) PG8_BAR; }
    PG8_BAR;
    if constexpr (Epi::AFTER_DRAIN) { E.fused(acc, cur, wr, wc, fr, fq, lds, wid, lane); S.done(cur); }
#undef PG8_SA
#undef PG8_SB
#undef PG8_STAGE
#undef PG8_LDA
#undef PG8_LDB
#undef PG8_MMA
#undef PG8_WAIT_V
#undef PG8_WAIT_L
#undef PG8_BAR
#undef PG8_SCHED
}
}

#define RLX_AGENT __ATOMIC_RELAXED, __HIP_MEMORY_SCOPE_AGENT
#define LDS_WAIT() asm volatile("s_waitcnt lgkmcnt(0)" ::: "memory")
#define VM_WAIT() asm volatile("s_waitcnt vmcnt(0)" ::: "memory")
#define XB_TMO      128
#define XB_XCNT(j)  (256  + 64 * (j))
#define XB_XSUB(j)  (1280 + 64 * (j))
#define XB_XGEN(j)  (2304 + 64 * (j))
#define XB_TOP      3328
#define XB_TOPGEN   3392
#define XCD_BAR_WORDS 3456
#define XB_SPIN_CAP (1u << 25)

__device__ __forceinline__ unsigned xb_ld(unsigned* p)              { return __hip_atomic_load(p, __ATOMIC_RELAXED, __HIP_MEMORY_SCOPE_AGENT); }
__device__ __forceinline__ unsigned xb_add(unsigned* p, unsigned v) { return __hip_atomic_fetch_add(p, v, __ATOMIC_RELAXED, __HIP_MEMORY_SCOPE_AGENT); }
__device__ __forceinline__ unsigned xb_xcc_id() { return (unsigned)__builtin_amdgcn_s_getreg((3 << 11) | 20) & 0xFu; }
#define XB_SPIN(cond, bar) do { unsigned _sp = 0; while (cond) { __builtin_amdgcn_s_sleep(1); \
    if ((++_sp & 255u) == 0u) { if (xb_ld(&(bar)[XB_TMO])) break; if (_sp > XB_SPIN_CAP) { atomicAdd(&(bar)[XB_TMO], 1u); break; } } } } while (0)

struct XcdBarrier {
    unsigned* bar; unsigned x;
    volatile LAS unsigned* st;
};

__device__ __forceinline__ XcdBarrier xcd_barrier_post(unsigned* bar, volatile LAS unsigned* st) {
    XcdBarrier b; b.bar = bar; b.x = xb_xcc_id(); b.st = st;
    if (threadIdx.x == 0) (void)xb_add(&bar[XB_XCNT(b.x)], 1u);
    return b;
}
__device__ __forceinline__ void xcd_barrier_complete(unsigned* bar, unsigned x, unsigned& nloc, unsigned& nx) {
    const unsigned G = gridDim.x * gridDim.y * gridDim.z;
    unsigned sum, cnt, mine, sp = 0u;
    for (;;) {
        sum = 0u; cnt = 0u; mine = 0u;
#pragma unroll
        for (unsigned j = 0; j < 16; ++j) { const unsigned c = xb_ld(&bar[XB_XCNT(j)]); sum += c; cnt += (c > 0u) ? 1u : 0u; mine = (j == x) ? c : mine; }
        if (sum == G) break;
        __builtin_amdgcn_s_sleep(1);
        if ((++sp & 255u) == 0u) { if (xb_ld(&bar[XB_TMO])) break; if (sp > XB_SPIN_CAP) { atomicAdd(&bar[XB_TMO], 1u); break; } }
    }
    nloc = mine > 0u ? mine : 1u; nx = cnt > 0u ? cnt : 1u;
}

__device__ __forceinline__ void xcd_barrier(const XcdBarrier& b) {
    asm volatile("s_waitcnt vmcnt(0)" ::: "memory");
    __syncthreads();
    if (threadIdx.x == 0) {
        unsigned* bar = b.bar;
        __builtin_amdgcn_s_waitcnt(0);
        unsigned nloc = b.st[0], nx = b.st[1];
        if (nloc == 0u) { xcd_barrier_complete(bar, b.x, nloc, nx); b.st[0] = nloc; b.st[1] = nx; }
        const unsigned old = xb_add(&bar[XB_XSUB(b.x)], 1u);
        const unsigned gen = old / nloc;
        if (old + 1u == (gen + 1u) * nloc) {
            __builtin_amdgcn_fence(__ATOMIC_RELEASE, "agent");
            asm volatile("s_waitcnt vmcnt(0)" ::: "memory");
            const unsigned og = xb_add(&bar[XB_TOP], 1u);
            const unsigned tg = og / nx;
            if (og + 1u == (tg + 1u) * nx) xb_add(&bar[XB_TOPGEN], 1u);
            else XB_SPIN(xb_ld(&bar[XB_TOPGEN]) == tg, bar);
            __builtin_amdgcn_fence(__ATOMIC_ACQUIRE, "agent");
            xb_add(&bar[XB_XGEN(b.x)], 1u);
            asm volatile("s_waitcnt vmcnt(0)" ::: "memory");
        } else {
            XB_SPIN(xb_ld(&bar[XB_XGEN(b.x)]) == gen, bar);
            __builtin_amdgcn_fence(__ATOMIC_ACQUIRE, "agent");
            asm volatile("s_waitcnt vmcnt(0)" ::: "memory");
        }
    }
    __syncthreads();
}
struct Args { const void* in[27]; float* out; unsigned char* ws; };
#define INF(i) ((const float*)args.in[i])
#define WSP(T, off) ((T*)(F.ws + (off)))
constexpr int NWAVES = 8;
constexpr int RING_OFF = 0, RING_BYTES = 131072;
constexpr int LDSCTL_OFF = RING_BYTES, MISC_OFF = LDSCTL_OFF + 320;
constexpr int LDS_BYTES = 147456;
static_assert(MISC_OFF + 128 <= LDS_BYTES, "LDS map");

struct Frame {
    LAS unsigned char* lds;
    volatile LAS unsigned* MISC;
    gu32* ctl;
    int tid, lane, wave, vcu, G;
    unsigned char* ws; float* out;
};

__device__ __forceinline__ int t5_bucket(int n) {
    if (n < 16) return n;
    const int b = 16 + (int)(__logf((float)n * (1.0f / 16.0f)) * (16.0f / 2.0794415416798357f));
    return b < 31 ? b : 31;
}

__device__ __forceinline__ void tr_item(const float* W, int ldw, int k0, int c0, const float* gain, bf16_t* WT, int ldt, int r0, LAS float* scr, int lane) {
    if (c0 >= 0) {
#pragma unroll 8
        for (int i = 0; i < 32; ++i) { const int kk = 2 * i + (lane >> 5); float v = W[(size_t)(k0 + kk) * ldw + c0 + (lane & 31)]; if (gain) v *= gain[k0 + kk]; scr[kk * 33 + (lane & 31)] = v; }
    } else {
#pragma unroll 8
        for (int i = 0; i < 32; ++i) { const int kk = 2 * i + (lane >> 5); scr[kk * 33 + (lane & 31)] = 0.f; }
    }
    LDS_WAIT(); asm volatile("" ::: "memory");
    const int c = lane & 7;
#pragma unroll
    for (int j = 0; j < 4; ++j) { const int n = (lane >> 3) + 8 * j; const LAS float* s = scr + (8 * c) * 33 + n;
        u32x4 o; o.x = pk2(s[0 * 33], s[1 * 33]); o.y = pk2(s[2 * 33], s[3 * 33]); o.z = pk2(s[4 * 33], s[5 * 33]); o.w = pk2(s[6 * 33], s[7 * 33]);
        *(u32x4*)(WT + (size_t)(r0 + n) * ldt + k0 + 8 * c) = o; }
    LDS_WAIT(); asm volatile("" ::: "memory");
}
__device__ __forceinline__ void sincos_d(double a, float& s, float& c) {
    const double q = __builtin_rint(a * 0.6366197723675814);
    double r = __builtin_fma(-q, 1.5707963267948966, a); r = __builtin_fma(-q, 6.123233995736766e-17, r);
    const double r2 = r * r;
    double sp = 1.0 / 6227020800.0; sp = sp * r2 - 1.0 / 39916800.0; sp = sp * r2 + 1.0 / 362880.0; sp = sp * r2 - 1.0 / 5040.0; sp = sp * r2 + 1.0 / 120.0; sp = sp * r2 - 1.0 / 6.0; sp = sp * r2 + 1.0; sp *= r;
    double cp = -1.0 / 87178291200.0; cp = cp * r2 + 1.0 / 479001600.0; cp = cp * r2 - 1.0 / 3628800.0; cp = cp * r2 + 1.0 / 40320.0; cp = cp * r2 - 1.0 / 720.0; cp = cp * r2 + 1.0 / 24.0; cp = cp * r2 - 0.5; cp = cp * r2 + 1.0;
    const int qi = (int)q & 3;
    const double ss = (qi == 0) ? sp : (qi == 1) ? cp : (qi == 2) ? -sp : -cp;
    const double cc = (qi == 0) ? cp : (qi == 1) ? -sp : (qi == 2) ? -cp : sp;
    s = (float)ss; c = (float)cc;
}
__device__ __forceinline__ void p0_prologue(Frame& F, const Args& args) {
    LAS float* scr = (LAS float*)(F.lds + RING_OFF + F.wave * 16384);
    const int gw = F.vcu * NWAVES + F.wave, NGW = F.G * NWAVES;
    constexpr int I13 = (D / 64) * (2 * FF / 32), I2 = (FF / 64) * (D / 32), IIN = (D / 64) * (ZLD / 32), IUQ = (QLORA / 64) * (QLD / 32), IUKV = (KVLORA / 64) * (2 * KLD / 32),
                  IOUT = (D / 64) * (D / 32), IG = IOUT, IPLE = (PLE / 64) * (D / 32);
    constexpr int NITEMS = 2 * I13 + 2 * I2 + IIN + IUQ + IUKV + IOUT + IG + IPLE;
    for (int it = gw; it < NITEMS; it += NGW) {
        int r = it;
        if (r < 2 * I13) {
            const bool second = r >= I13; if (second) r -= I13;
            const int nblk = 2 * FF / 32, kb = r / nblk, nb = r % nblk, j = nb >> 3, w = nb & 7, b = w >> 2, i0 = (w & 3) * 32;
            const float* src = INF(second ? (b ? 21 : 20) : (b ? 7 : 6));
            tr_item(src, FF, 64 * kb, 128 * j + i0, nullptr, WSP(bf16_t, second ? WS_W13B : WS_W13A), D, 32 * nb, scr, F.lane); continue; }
        r -= 2 * I13;
        if (r < 2 * I2) { const bool second = r >= I2; if (second) r -= I2;
            const int nblk = D / 32, kb = r / nblk, nb = r % nblk;
            tr_item(INF(second ? 22 : 8), D, 64 * kb, 32 * nb, nullptr, WSP(bf16_t, second ? WS_W2B : WS_W2A), FF, 32 * nb, scr, F.lane); continue; }
        r -= 2 * I2;
        if (r < IIN) { const int nblk = ZLD / 32, kb = r / nblk, nb = r % nblk, r0 = 32 * nb;
            int c0;
            if (r0 < 1024) c0 = r0; else if (r0 < 2048) c0 = 1088 + (r0 - 1024); else if (r0 < 2304) c0 = 2112 + (r0 - 2048); else if (r0 == 2304) c0 = 1024; else if (r0 == 2432) c0 = 1056; else c0 = -1;
            tr_item(INF(9), DIN, 64 * kb, c0, nullptr, WSP(bf16_t, WS_WIN), D, r0, scr, F.lane); continue; }
        r -= IIN;
        if (r < IUQ) { const int nblk = QLD / 32, kb = r / nblk, nb = r % nblk, r0 = 32 * nb;
            int c0;
            if (r0 < 1024) c0 = QKD * (r0 >> 7) + (r0 & 127);
            else { const int t = (r0 - 1024) >> 8, b = ((r0 - 1024) >> 7) & 1, w = (r0 & 127) >> 5; c0 = QKD * (4 * t + w) + NOPE + 32 * b; }
            tr_item(INF(11), QLD, 64 * kb, c0, INF(10), WSP(bf16_t, WS_WUQ), QLORA, r0, scr, F.lane); continue; }
        r -= IUQ;
        if (r < IUKV) { const int nblk = 2 * KLD / 32, kb = r / nblk, nb = r % nblk;
            tr_item(INF(13), 2 * KLD, 64 * kb, 32 * nb, INF(12), WSP(bf16_t, WS_WUKV), KVLORA, 32 * nb, scr, F.lane); continue; }
        r -= IUKV;
        if (r < IOUT) { const int nblk = D / 32, kb = r / nblk, nb = r % nblk, k0 = 64 * kb;
            tr_item(INF(17), D, k0, 32 * nb, k0 < 1024 ? INF(15) : INF(16) - 1024, WSP(bf16_t, WS_WOUT), D, 32 * nb, scr, F.lane); continue; }
        r -= IOUT;
        if (r < IG) { const int nblk = D / 32, kb = r / nblk, nb = r % nblk;
            tr_item(INF(25), D, 64 * kb, 32 * nb, nullptr, WSP(bf16_t, WS_WG), D, 32 * nb, scr, F.lane); continue; }
        r -= IG;
        { const int nblk = D / 32, kb = r / nblk, nb = r % nblk;
            tr_item(INF(26), D, 64 * kb, 32 * nb, nullptr, WSP(bf16_t, WS_WPLE), PLE, 32 * nb, scr, F.lane); }
    }
    const int gt = F.vcu * (NWAVES * 64) + F.tid, NGT = F.G * NWAVES * 64;
    for (int i = gt; i < M * D / 8; i += NGT) { const f32x4 a = ((const f32x4*)INF(0))[2 * i], b = ((const f32x4*)INF(0))[2 * i + 1];
        u32x4 o; o.x = pk2(a[0], a[1]); o.y = pk2(a[2], a[3]); o.z = pk2(b[0], b[1]); o.w = pk2(b[2], b[3]); ((u32x4*)WSP(bf16_t, WS_HB))[i] = o; }
    for (int i = gt; i < M * PLE / 8; i += NGT) { const f32x4 a = ((const f32x4*)INF(1))[2 * i], b = ((const f32x4*)INF(1))[2 * i + 1];
        u32x4 o; o.x = pk2(a[0], a[1]); o.y = pk2(a[2], a[3]); o.z = pk2(b[0], b[1]); o.w = pk2(b[2], b[3]); ((u32x4*)WSP(bf16_t, WS_PB))[i] = o; }
    for (int i = gt; i < M * 32; i += NGT) { const int row = i >> 5, fi = i & 31; double fr = 1.0; for (int k = 0; k < fi; ++k) fr *= 0.7498942093324559;
        float s, c; sincos_d((double)((const int*)args.in[2])[row] * fr, s, c); WSP(float, WS_COS)[i] = c; WSP(float, WS_SIN)[i] = s; }
    for (int i = gt; i < SWH * WINDOW; i += NGT) { const int h = i >> 7, dist = i & 127; WSP(float, WS_BIAS)[i] = INF(3)[t5_bucket(dist) * SWH + h] * LOG2E; }
}

__device__ __forceinline__ void ln_pass(Frame& F, float* io, const float* g, const float* b, bf16_t* hb) {
    const int gw = F.vcu * NWAVES + F.wave, NGW = F.G * NWAVES;
    for (int m = gw; m < M; m += NGW) {
        f32x4* xr = (f32x4*)(io + (size_t)m * D) + F.lane;
        f32x4 v[8]; float s = 0.f;
#pragma unroll
        for (int j = 0; j < 8; ++j) { v[j] = xr[64 * j]; s += (v[j][0] + v[j][1]) + (v[j][2] + v[j][3]); }
        const float mean = wave_sum(s) * (1.0f / D); float s2 = 0.f;
#pragma unroll
        for (int j = 0; j < 8; ++j) { v[j] = v[j] - mean; s2 += (v[j][0] * v[j][0] + v[j][1] * v[j][1]) + (v[j][2] * v[j][2] + v[j][3] * v[j][3]); }
        const float rstd = 1.0f / sqrtf(wave_sum(s2) * (1.0f / D) + LN_EPS);
        u32x2* o8 = (u32x2*)(hb + (size_t)m * D) + F.lane;
#pragma unroll
        for (int j = 0; j < 8; ++j) { const f32x4 gg = ((const f32x4*)g)[F.lane + 64 * j], bb = ((const f32x4*)b)[F.lane + 64 * j]; const f32x4 o = v[j] * rstd * gg + bb;
            xr[64 * j] = o; u32x2 w; w.x = pk2(o[0], o[1]); w.y = pk2(o[2], o[3]); o8[64 * j] = w; }
    }
}
__device__ __forceinline__ void norm_mix_pass(Frame& F) {
    const int gw = F.vcu * NWAVES + F.wave, NGW = F.G * NWAVES;
    for (int m = gw; m < M; m += NGW) {
        u32x4* ar = (u32x4*)(WSP(bf16_t, WS_AMIX) + (size_t)m * D) + F.lane;
        float v[4][8]; float s[2] = {0.f, 0.f};
#pragma unroll
        for (int j = 0; j < 4; ++j) { const u32x4 w = ar[64 * j];
#pragma unroll
            for (int e = 0; e < 4; ++e) { v[j][2 * e] = __uint_as_float(w[e] << 16); v[j][2 * e + 1] = __uint_as_float(w[e] & 0xffff0000u); }
#pragma unroll
            for (int e = 0; e < 8; ++e) s[j >> 1] += v[j][e] * v[j][e]; }
        const float r0 = 1.0f / sqrtf(wave_sum(s[0]) * (1.0f / 1024.0f) + LN_EPS), r1 = 1.0f / sqrtf(wave_sum(s[1]) * (1.0f / 1024.0f) + LN_EPS);
#pragma unroll
        for (int j = 0; j < 4; ++j) { const float r = (j < 2) ? r0 : r1; u32x4 w;
#pragma unroll
            for (int e = 0; e < 4; ++e) w[e] = pk2(v[j][2 * e] * r, v[j][2 * e + 1] * r);
            ar[64 * j] = w; }
    }
}

__device__ __forceinline__ void mla_attn_naive(Frame& F) {
    LAS float* qs = (LAS float*)(F.lds + F.wave * 8192); LAS float* sc = qs + 256;
    const int gw = F.vcu * NWAVES + F.wave, NGW = F.G * NWAVES, lane = F.lane;
    for (int task = gw; task < M * NH; task += NGW) {
        const int head = task & 7, q = task >> 3;
        const bf16_t* qp = WSP(bf16_t, WS_Q) + (size_t)q * QLD + head * QKD;
        asm volatile("" ::: "memory");
#pragma unroll
        for (int j = 0; j < 3; ++j) qs[lane + 64 * j] = bf2f(qp[lane + 64 * j]);
        LDS_WAIT(); asm volatile("" ::: "memory");
        float m = -INFINITY, l = 0.f, a0 = 0.f, a1 = 0.f;
        for (int c0 = 0; c0 <= q; c0 += 1024) {
            const int nk = (q + 1 - c0) < 1024 ? (q + 1 - c0) : 1024;
            float cmax = -INFINITY;
            for (int kk = lane; kk < nk; kk += 64) {
                const int key = c0 + kk;
                const bf16_t* kp = WSP(bf16_t, WS_K) + (size_t)key * KLD + head * NOPE; const bf16_t* rp = WSP(bf16_t, WS_KR) + (size_t)key * 64;
                float s = 0.f;
                for (int c = 0; c < 16; ++c) { const bf16x8 kv = *(const bf16x8*)(kp + 8 * c);
#pragma unroll
                    for (int e = 0; e < 8; ++e) s += qs[8 * c + e] * bf2f((bf16_t)kv[e]); }
                for (int c = 0; c < 8; ++c) { const bf16x8 kv = *(const bf16x8*)(rp + 8 * c);
#pragma unroll
                    for (int e = 0; e < 8; ++e) s += qs[NOPE + 8 * c + e] * bf2f((bf16_t)kv[e]); }
                sc[kk] = s; cmax = fmaxf(cmax, s);
            }
            cmax = wave_max(cmax);
            const float mn = fmaxf(m, cmax), f = exp2f(m - mn);
            l *= f; a0 *= f; a1 *= f; m = mn;
            float ps = 0.f;
            for (int kk = lane; kk < nk; kk += 64) { const float pv = exp2f(sc[kk] - mn); sc[kk] = pv; ps += pv; }
            l += wave_sum(ps);
            LDS_WAIT(); asm volatile("" ::: "memory");
            const bf16_t* vp = WSP(bf16_t, WS_V) + (size_t)c0 * KLD + head * VD + 2 * lane;
            int kk = 0;
            for (; kk + 8 <= nk; kk += 8) { unsigned vv[8];
#pragma unroll
                for (int e = 0; e < 8; ++e) vv[e] = *(const unsigned*)(vp + (size_t)(kk + e) * KLD);
#pragma unroll
                for (int e = 0; e < 8; ++e) { const float pv = sc[kk + e]; a0 += pv * __uint_as_float(vv[e] << 16); a1 += pv * __uint_as_float(vv[e] & 0xffff0000u); } }
            for (; kk < nk; ++kk) { const float pv = sc[kk]; const unsigned vv = *(const unsigned*)(vp + (size_t)kk * KLD); a0 += pv * __uint_as_float(vv << 16); a1 += pv * __uint_as_float(vv & 0xffff0000u); }
            LDS_WAIT(); asm volatile("" ::: "memory");
        }
        const float il = 1.0f / l;
        *(unsigned*)(WSP(bf16_t, WS_AMIX) + (size_t)q * D + head * VD + 2 * lane) = pk2(a0 * il, a1 * il);
    }
}
__device__ __forceinline__ void swa_attn_naive(Frame& F, const Args& args) {
    LAS float* qs = (LAS float*)(F.lds + F.wave * 8192); LAS float* sc = qs + 256;
    const int gw = F.vcu * NWAVES + F.wave, NGW = F.G * NWAVES, lane = F.lane;
    for (int task = gw; task < M * SWH; task += NGW) {
        const int h = task & 15, q = task >> 4, kvh = h >> 3;
        asm volatile("" ::: "memory");
        qs[lane] = bf2f(WSP(bf16_t, WS_Z)[(size_t)q * ZLD + Z_QS + h * SWD + lane]);
        LDS_WAIT(); asm volatile("" ::: "memory");
        float sv[2];
#pragma unroll
        for (int t = 0; t < 2; ++t) { const int dist = lane + 64 * t, key = q - dist; float s = -INFINITY;
            if (key >= 0) { const bf16_t* kp = WSP(bf16_t, WS_Z) + (size_t)key * ZLD + Z_KS + kvh * SWD; float d = 0.f;
                for (int c = 0; c < 8; ++c) { const bf16x8 kv = *(const bf16x8*)(kp + 8 * c);
#pragma unroll
                    for (int e = 0; e < 8; ++e) d += qs[8 * c + e] * bf2f((bf16_t)kv[e]); }
                s = d * SWA_SCALE2 + WSP(float, WS_BIAS)[h * WINDOW + dist]; }
            sv[t] = s; }
        const float sink2 = INF(14)[h] * LOG2E;
        const float mx = fmaxf(wave_max(fmaxf(sv[0], sv[1])), sink2);
        const float e0 = exp2f(sv[0] - mx), e1 = exp2f(sv[1] - mx);
        sc[lane] = e0; sc[lane + 64] = e1;
        const float denom = wave_sum(e0 + e1) + exp2f(sink2 - mx);
        LDS_WAIT(); asm volatile("" ::: "memory");
        float acc = 0.f;
        const int nd = (q + 1) < WINDOW ? (q + 1) : WINDOW;
        int dist = 0;
        for (; dist + 8 <= nd; dist += 8) { bf16_t vv[8];
#pragma unroll
            for (int e = 0; e < 8; ++e) vv[e] = WSP(bf16_t, WS_Z)[(size_t)(q - dist - e) * ZLD + Z_VS + kvh * SWD + lane];
#pragma unroll
            for (int e = 0; e < 8; ++e) acc += sc[dist + e] * bf2f(vv[e]); }
        for (; dist < nd; ++dist) acc += sc[dist] * bf2f(WSP(bf16_t, WS_Z)[(size_t)(q - dist) * ZLD + Z_VS + kvh * SWD + lane]);
        WSP(bf16_t, WS_AMIX)[(size_t)q * D + 1024 + h * SWD + lane] = (bf16_t)f2bf(acc / denom);
        LDS_WAIT(); asm volatile("" ::: "memory");
    }
}
#ifndef STOP_AFTER
#define STOP_AFTER 99
#endif
#ifndef FAST_GEMM
#define FAST_GEMM 0
#endif
#if FAST_GEMM
#define RUN_GEMM(EPI, g, S, E, ALIGN) pg8::gemm_phase<EPI, pg8::StaticOrder, ALIGN, true>(F.lds + RING_OFF, g, S, E)
#else
#define RUN_GEMM(EPI, g, S, E, ALIGN) pg8::gemm_ref<EPI, pg8::StaticOrder>(g, S, E)
#endif

__global__ void __launch_bounds__(NWAVES * 64, 2) fwd_kernel(Args args) {
    extern __shared__ __attribute__((aligned(16))) unsigned char lds[];
    Frame F;
    F.lds = (LAS unsigned char*)lds;
    F.MISC = (volatile LAS unsigned*)(F.lds + MISC_OFF);
    F.tid = threadIdx.x; F.lane = F.tid & 63; F.wave = __builtin_amdgcn_readfirstlane(F.tid >> 6);
    F.G = gridDim.x; { const int bx = blockIdx.x; F.vcu = (F.G % 8 == 0) ? (bx % 8) * (F.G / 8) + bx / 8 : bx; }
    unsigned char* ws = args.ws;
    F.ctl = (gu32*)(ws + WS_CTL);
    F.ws = ws; F.out = args.out;

    for (int u = F.tid; u < (LDS_BYTES - LDSCTL_OFF) / 4; u += NWAVES * 64) ((LAS unsigned*)(F.lds + LDSCTL_OFF))[u] = 0u;
    __syncthreads();
    XcdBarrier bar = xcd_barrier_post((unsigned*)(F.ctl + CW_BAR), F.MISC + 8);
#define GRID_BAR() xcd_barrier(bar)
    const int cid = (int)blockIdx.x;

    p0_prologue(F, args);
    GRID_BAR();
    if (STOP_AFTER < 1) return;
    { pg8::Gemm g{WSP(bf16_t, WS_HB), WSP(bf16_t, WS_W13A), M, 2 * FF, D, D, D}; pg8::StaticOrder S; S.init(M, 2 * FF, F.G, cid); pg8::EpiSwiGLU E{WSP(bf16_t, WS_G), FF}; RUN_GEMM(pg8::EpiSwiGLU, g, S, E, true); }
    GRID_BAR();
    if (STOP_AFTER < 2) return;
    { pg8::Gemm g{WSP(bf16_t, WS_G), WSP(bf16_t, WS_W2A), M, D, FF, FF, FF}; pg8::StaticOrder S; S.init(M, D, F.G, cid); pg8::EpiResid E{INF(0), F.out, D, ALPHA, 0.5f}; RUN_GEMM(pg8::EpiResid, g, S, E, false); }
    GRID_BAR();
    if (STOP_AFTER < 3) return;
    ln_pass(F, F.out, INF(4), INF(5), WSP(bf16_t, WS_HB));
    GRID_BAR();
    if (STOP_AFTER < 4) return;
    { pg8::Gemm g{WSP(bf16_t, WS_HB), WSP(bf16_t, WS_WIN), M, ZLD, D, D, D}; pg8::StaticOrder S; S.init(M, ZLD, F.G, cid); pg8::EpiZ E{WSP(bf16_t, WS_Z), WSP(float, WS_SSQ), WSP(bf16_t, WS_KR), WSP(float, WS_COS), WSP(float, WS_SIN)}; RUN_GEMM(pg8::EpiZ, g, S, E, true); }
    GRID_BAR();
    if (STOP_AFTER < 5) return;
    { pg8::Gemm g{WSP(bf16_t, WS_Z) + Z_CQ, WSP(bf16_t, WS_WUQ), M, QLD, QLORA, ZLD, QLORA}; pg8::StaticOrder S; S.init(M, QLD, F.G, cid); pg8::EpiQ E{WSP(bf16_t, WS_Q), WSP(float, WS_SSQ), WSP(float, WS_COS), WSP(float, WS_SIN), MLA_QSCALE}; RUN_GEMM(pg8::EpiQ, g, S, E, true); }
    { pg8::Gemm g{WSP(bf16_t, WS_Z) + Z_CKV, WSP(bf16_t, WS_WUKV), M, 2 * KLD, KVLORA, ZLD, KVLORA}; pg8::StaticOrder S; S.init(M, 2 * KLD, F.G, cid); pg8::EpiKV E{WSP(bf16_t, WS_K), WSP(bf16_t, WS_V), WSP(float, WS_SSQ)}; RUN_GEMM(pg8::EpiKV, g, S, E, true); }
    GRID_BAR();
    if (STOP_AFTER < 6) return;
    mla_attn_naive(F);
    swa_attn_naive(F, args);
    GRID_BAR();
    if (STOP_AFTER < 7) return;
    norm_mix_pass(F);
    GRID_BAR();
    if (STOP_AFTER < 8) return;
    { pg8::Gemm g{WSP(bf16_t, WS_AMIX), WSP(bf16_t, WS_WOUT), M, D, D, D, D}; pg8::StaticOrder S; S.init(M, D, F.G, cid); pg8::EpiResid E{F.out, F.out, D, ALPHA, 1.0f}; RUN_GEMM(pg8::EpiResid, g, S, E, false); }
    GRID_BAR();
    if (STOP_AFTER < 9) return;
    ln_pass(F, F.out, INF(18), INF(19), WSP(bf16_t, WS_HB));
    GRID_BAR();
    if (STOP_AFTER < 10) return;
    { pg8::Gemm g{WSP(bf16_t, WS_HB), WSP(bf16_t, WS_W13B), M, 2 * FF, D, D, D}; pg8::StaticOrder S; S.init(M, 2 * FF, F.G, cid); pg8::EpiSwiGLU E{WSP(bf16_t, WS_G), FF}; RUN_GEMM(pg8::EpiSwiGLU, g, S, E, true); }
    GRID_BAR();
    if (STOP_AFTER < 11) return;
    { pg8::Gemm g{WSP(bf16_t, WS_G), WSP(bf16_t, WS_W2B), M, D, FF, FF, FF}; pg8::StaticOrder S; S.init(M, D, F.G, cid); pg8::EpiResid E{F.out, F.out, D, ALPHA, 0.5f}; RUN_GEMM(pg8::EpiResid, g, S, E, false); }
    GRID_BAR();
    if (STOP_AFTER < 12) return;
    ln_pass(F, F.out, INF(23), INF(24), WSP(bf16_t, WS_HB));
    GRID_BAR();
    if (STOP_AFTER < 13) return;
    { pg8::Gemm g{WSP(bf16_t, WS_PB), WSP(bf16_t, WS_WPLE), M, D, PLE, PLE, PLE}; pg8::StaticOrder S; S.init(M, D, F.G, cid); pg8::EpiBf16 E{WSP(bf16_t, WS_PL), D}; RUN_GEMM(pg8::EpiBf16, g, S, E, false); }
    { pg8::Gemm g{WSP(bf16_t, WS_HB), WSP(bf16_t, WS_WG), M, D, D, D, D}; pg8::StaticOrder S; S.init(M, D, F.G, cid); pg8::EpiGate E{F.out, WSP(bf16_t, WS_PL), D}; RUN_GEMM(pg8::EpiGate, g, S, E, false); }
}

extern "C" void kernel_launch(void* const* d_in, const int* in_sizes, int n_in, void* d_out, int out_size, void* d_ws, size_t ws_size, hipStream_t stream) {
    static int grid = 0;
    if (grid == 0) {
        if (n_in != 27 || in_sizes[0] != M * D || out_size != M * D || ws_size < WS_END) { fprintf(stderr, "kernel_launch: unexpected shapes / workspace (n_in %d, in0 %d, out %d, ws %zu, need %zu); nothing launched\n", n_in, n_in > 0 ? in_sizes[0] : -1, out_size, ws_size, (size_t)WS_END); grid = -1; return; }
        int dev = 0, cus = 0;
        if (hipGetDevice(&dev) != hipSuccess || hipDeviceGetAttribute(&cus, hipDeviceAttributeMultiprocessorCount, dev) != hipSuccess) { grid = -1; return; }
        if (hipFuncSetAttribute((const void*)fwd_kernel, hipFuncAttributeMaxDynamicSharedMemorySize, LDS_BYTES) != hipSuccess) { fprintf(stderr, "kernel_launch: hipFuncSetAttribute failed\n"); grid = -1; return; }
        int per_cu = 0;
        if (hipOccupancyMaxActiveBlocksPerMultiprocessor(&per_cu, (const void*)fwd_kernel, NWAVES * 64, LDS_BYTES) != hipSuccess || per_cu < 1) fprintf(stderr, "kernel_launch: occupancy query reports %d\n", per_cu);
        (void)hipGetLastError();
        grid = cus;
    }
    if (grid < 0) return;
    if (hipMemsetAsync((char*)d_ws + WS_CTL, 0, CTL_ZERO_BYTES, stream) != hipSuccess) return;
    Args a{};
    for (int i = 0; i < 27; ++i) a.in[i] = d_in[i];
    a.out = (float*)d_out; a.ws = (unsigned char*)d_ws;
    hipLaunchKernelGGL(fwd_kernel, dim3(grid), dim3(NWAVES * 64), LDS_BYTES, stream, a);
}
```

```cpp
#include <hip/hip_runtime.h>
#include <cstdio>
#include <cstdint>

#define LAS __attribute__((address_space(3)))
#define GAS __attribute__((address_space(1)))
typedef unsigned short bf16_t;
typedef short bf16x8 __attribute__((ext_vector_type(8)));
typedef float f32x4 __attribute__((ext_vector_type(4)));
typedef float f32x2 __attribute__((ext_vector_type(2)));
typedef unsigned u32x4 __attribute__((ext_vector_type(4)));
typedef unsigned u32x2 __attribute__((ext_vector_type(2)));
typedef GAS unsigned gu32;

constexpr int M = 8192, D = 2048, FF = 5632, PLE = 256, DIN = 2368;
constexpr int ZLD = 2560;
constexpr int NH = 8, NOPE = 128, ROPE = 64, QKD = 192, VD = 128, QLORA = 512, KVLORA = 512;
constexpr int QLD = NH * QKD;
constexpr int KLD = NH * NOPE;
constexpr int SWH = 16, SWKV = 2, SWD = 64, WINDOW = 128;
constexpr float ALPHA = 1.189207115002721f, LN_EPS = 1e-5f;
constexpr float LOG2E = 1.4426950408889634f;
constexpr float MLA_QSCALE = 0.10411754627697264f;
constexpr float SWA_SCALE2 = 0.18033688011112042f;
constexpr int Z_CQ = 0, Z_CKV = 512, Z_QS = 1024, Z_KS = 2048, Z_VS = 2176;

constexpr size_t MiB = 1u << 20;
constexpr size_t WS_CTL = 0, CTL_ZERO_BYTES = 1 * MiB;
constexpr size_t WS_COS = 1 * MiB, WS_SIN = 2 * MiB;
constexpr size_t WS_BIAS = 3 * MiB;
constexpr size_t WS_SSQ = 3 * MiB + 65536;
constexpr size_t WS_W13A = 4 * MiB;
constexpr size_t WS_W2A = WS_W13A + 44 * MiB;
constexpr size_t WS_W13B = WS_W2A + 22 * MiB;
constexpr size_t WS_W2B = WS_W13B + 44 * MiB;
constexpr size_t WS_WIN = WS_W2B + 22 * MiB;
constexpr size_t WS_WUQ = WS_WIN + 10 * MiB;
constexpr size_t WS_WUKV = WS_WUQ + 2 * MiB;
constexpr size_t WS_WOUT = WS_WUKV + 2 * MiB;
constexpr size_t WS_WG = WS_WOUT + 8 * MiB;
constexpr size_t WS_WPLE = WS_WG + 8 * MiB;
constexpr size_t WS_HB = WS_WPLE + 1 * MiB;
constexpr size_t WS_PB = WS_HB + 32 * MiB;
constexpr size_t WS_PL = WS_PB + 4 * MiB;
constexpr size_t WS_R = WS_PL + 32 * MiB;
constexpr size_t WS_G = WS_R;
constexpr size_t WS_Z = WS_R;
constexpr size_t WS_Q = WS_Z + 40 * MiB;
constexpr size_t WS_K = WS_Q + 24 * MiB;
constexpr size_t WS_V = WS_K + 16 * MiB;
constexpr size_t WS_KR = WS_V + 16 * MiB;
constexpr size_t WS_AMIX = WS_KR + 1 * MiB;
constexpr size_t WS_END = WS_AMIX + 32 * MiB;
static_assert(WS_G + (size_t)M * FF * 2 <= WS_END, "G overlay fits");
constexpr int CW_BAR = 4096;

__device__ __forceinline__ float bf2f(bf16_t b) { return __uint_as_float((unsigned)b << 16); }
__device__ __forceinline__ unsigned f2bf(float f) { unsigned u = __float_as_uint(f); return (u + 0x7fffu + ((u >> 16) & 1u)) >> 16; }
__device__ __forceinline__ unsigned pk2(float lo, float hi) { return f2bf(lo) | (f2bf(hi) << 16); }
__device__ __forceinline__ float wave_sum(float v) {
#pragma unroll
    for (int o = 1; o < 64; o <<= 1) v += __shfl_xor(v, o);
    return v;
}
__device__ __forceinline__ float wave_max(float v) {
#pragma unroll
    for (int o = 1; o < 64; o <<= 1) v = fmaxf(v, __shfl_xor(v, o));
    return v;
}
__device__ __forceinline__ int opaque_tid() { int t = threadIdx.x; asm volatile("" : "+v"(t)); return t; }
namespace pg8 {
#define PG8_LAS __attribute__((address_space(3)))
constexpr int BM = 256, BK = 64, HALF = 128, HTB = HALF * BK * 2  , STAGE_BYTES = 8 * HTB, NXCD = 8, WGM = 8;

__host__ __device__ __forceinline__ int lds_byte(int r, int c) { const int st = (r >> 4) * 2 + (c >> 5), rr = r & 15, cc = c & 31, ob = rr * 64 + cc * 2; return st * 1024 + (ob ^ (((ob >> 9) & 1) << 5)); }
__host__ __device__ __forceinline__ void stage_rc(int b, int& R, int& C) { const int st = b / 1024, sb = b % 1024, swz = sb ^ (((sb >> 9) & 1) << 5); R = (st >> 1) * 16 + swz / 64; C = (st & 1) * 32 + (swz % 64) / 2; }
__host__ __device__ __forceinline__ int perm32(int rho) { const int n = rho >> 4, i = rho & 15; return 8 * (i >> 2) + 4 * n + (i & 3); }

struct Unit { int pm, pn; };
struct Gemm { const bf16_t* A; const bf16_t* Bt; int M, N, K, lda, ldb; };

struct StaticOrder {
    int nM, nN, nwg, G, c;
    __host__ __device__ void init(int M_, int N_, int G_, int c_) { nM = M_ / BM; nN = N_ / BM; nwg = nM * nN; G = G_; c = c_; }
    __host__ __device__ bool next(int i, Unit& u) const {
        const long L = (long)i * G + c; if (L >= nwg) return false;
        int wgid = (int)L; { const int q = nwg / NXCD, r = nwg % NXCD, xcd = wgid % NXCD, off = wgid / NXCD; wgid = (xcd < r ? xcd * (q + 1) : r * (q + 1) + (xcd - r) * q) + off; }
        const int nig = WGM * nN, gid = wgid / nig, fm = gid * WGM, gsz = (nM - fm) < WGM ? (nM - fm) : WGM;
        u.pm = fm + ((wgid % nig) % gsz); u.pn = (wgid % nig) / gsz; return true;
    }
    __device__ __forceinline__ void a_ready(const Unit&) const {}
    __device__ __forceinline__ void done(const Unit&) const {}
};

typedef __bf16 bf16x2_t __attribute__((ext_vector_type(2)));
__device__ __forceinline__ unsigned cvt_pk_bf16(float lo, float hi) { const f32x2 v = {lo, hi}; const bf16x2_t b = __builtin_convertvector(v, bf16x2_t); return __builtin_bit_cast(unsigned, b); }
__device__ __forceinline__ u32x4 pack8(const f32x4 v0, const f32x4 v1) { u32x4 w; w.x = cvt_pk_bf16(v0[0], v0[1]); w.y = cvt_pk_bf16(v0[2], v0[3]); w.z = cvt_pk_bf16(v1[0], v1[1]); w.w = cvt_pk_bf16(v1[2], v1[3]); return w; }
__device__ __forceinline__ float sigmoidf_fast(float v) { return __builtin_amdgcn_rcpf(1.0f + __builtin_amdgcn_exp2f(-v * 1.4426950408889634f)); }

struct EpiBf16 {
    static constexpr bool PERM = true, AFTER_DRAIN = false;
    bf16_t* O; int ldc;
    __device__ __forceinline__ void operator()(const f32x4 (&acc)[2][2][4][2], const Unit& u, int wr, int wc, int fr, int fq) const {
        const int row0 = u.pm * BM + wr * 64 + fr, col0 = u.pn * BM + wc * 32 + 8 * fq;
#pragma unroll
        for (int ai = 0; ai < 2; ++ai)
#pragma unroll
            for (int m = 0; m < 4; ++m) { bf16_t* rowp = O + (size_t)(row0 + ai * HALF + m * 16) * ldc + col0;
#pragma unroll
                for (int bj = 0; bj < 2; ++bj) *(u32x4*)(rowp + bj * HALF) = pack8(acc[ai][bj][m][0], acc[ai][bj][m][1]); }
    }
};
struct EpiSwiGLU {
    static constexpr bool PERM = true, AFTER_DRAIN = false;
    bf16_t* G; int ldc;
    __device__ __forceinline__ void operator()(const f32x4 (&acc)[2][2][4][2], const Unit& u, int wr, int wc, int fr, int fq) const {
        const int row0 = u.pm * BM + wr * 64 + fr, col0 = u.pn * HALF + wc * 32 + 8 * fq;
#pragma unroll
        for (int ai = 0; ai < 2; ++ai)
#pragma unroll
            for (int m = 0; m < 4; ++m) { bf16_t* rowp = G + (size_t)(row0 + ai * HALF + m * 16) * ldc + col0;
                f32x4 g[2];
#pragma unroll
                for (int n = 0; n < 2; ++n)
#pragma unroll
                    for (int e = 0; e < 4; ++e) { const float a = acc[ai][0][m][n][e], b = acc[ai][1][m][n][e]; g[n][e] = a * sigmoidf_fast(a) * b; }
                *(u32x4*)rowp = pack8(g[0], g[1]); }
    }
};
struct EpiResid {
    static constexpr bool PERM = false, AFTER_DRAIN = false;
    const float* res; float* out; int ldc; float alpha, s;
    __device__ __forceinline__ void operator()(const f32x4 (&acc)[2][2][4][2], const Unit& u, int wr, int wc, int fr, int fq) const {
        const int row0 = u.pm * BM + wr * 64 + fr, col0 = u.pn * BM + wc * 32 + 4 * fq;
#pragma unroll
        for (int ai = 0; ai < 2; ++ai)
#pragma unroll
            for (int m = 0; m < 4; ++m) { const size_t off = (size_t)(row0 + ai * HALF + m * 16) * ldc + col0;
#pragma unroll
                for (int bj = 0; bj < 2; ++bj)
#pragma unroll
                    for (int n = 0; n < 2; ++n) { const f32x4 r = *(const f32x4*)(res + off + bj * HALF + n * 16); *(f32x4*)(out + off + bj * HALF + n * 16) = r * alpha + acc[ai][bj][m][n] * s; } }
    }
};
struct EpiGate {
    static constexpr bool PERM = false, AFTER_DRAIN = false;
    float* out; const bf16_t* pl; int ldc;
    __device__ __forceinline__ void operator()(const f32x4 (&acc)[2][2][4][2], const Unit& u, int wr, int wc, int fr, int fq) const {
        const int row0 = u.pm * BM + wr * 64 + fr, col0 = u.pn * BM + wc * 32 + 4 * fq;
#pragma unroll
        for (int ai = 0; ai < 2; ++ai)
#pragma unroll
            for (int m = 0; m < 4; ++m) { const size_t off = (size_t)(row0 + ai * HALF + m * 16) * ldc + col0;
#pragma unroll
                for (int bj = 0; bj < 2; ++bj)
#pragma unroll
                    for (int n = 0; n < 2; ++n) { const size_t o = off + bj * HALF + n * 16; const f32x4 h = *(const f32x4*)(out + o); const u32x2 pw = *(const u32x2*)(pl + o);
                        f32x4 p; p[0] = __uint_as_float(pw.x << 16); p[1] = __uint_as_float(pw.x & 0xffff0000u); p[2] = __uint_as_float(pw.y << 16); p[3] = __uint_as_float(pw.y & 0xffff0000u);
                        f32x4 r;
#pragma unroll
                        for (int e = 0; e < 4; ++e) r[e] = h[e] + sigmoidf_fast(acc[ai][bj][m][n][e]) * p[e];
                        *(f32x4*)(out + o) = r; } }
    }
};
struct EpiZ {
    static constexpr bool PERM = true, AFTER_DRAIN = false;
    bf16_t* Z; float* ssq; bf16_t* KR; const float* cs; const float* sn;
    __device__ __forceinline__ void operator()(const f32x4 (&acc)[2][2][4][2], const Unit& u, int wr, int wc, int fr, int fq) const {
        const int row0 = u.pm * BM + wr * 64 + fr;
        if (u.pn < 9) {
            const int col0 = u.pn * BM + wc * 32 + 8 * fq;
#pragma unroll
            for (int ai = 0; ai < 2; ++ai)
#pragma unroll
                for (int m = 0; m < 4; ++m) { const int row = row0 + ai * HALF + m * 16; bf16_t* rowp = Z + (size_t)row * ZLD + col0;
#pragma unroll
                    for (int bj = 0; bj < 2; ++bj) *(u32x4*)(rowp + bj * HALF) = pack8(acc[ai][bj][m][0], acc[ai][bj][m][1]);
                    if (u.pn < 4) { float s = 0.f;
#pragma unroll
                        for (int bj = 0; bj < 2; ++bj)
#pragma unroll
                            for (int n = 0; n < 2; ++n) { const f32x4 x = acc[ai][bj][m][n]; s += (x[0] * x[0] + x[1] * x[1]) + (x[2] * x[2] + x[3] * x[3]); }
                        s += __shfl_xor(s, 16); s += __shfl_xor(s, 32);
                        if (fq == 0) ssq[(size_t)row * 16 + u.pn * 4 + wc] = s; } }
        } else if (wc == 0) {
#pragma unroll
            for (int ai = 0; ai < 2; ++ai)
#pragma unroll
                for (int m = 0; m < 4; ++m) { const int row = row0 + ai * HALF + m * 16; f32x4 o1[2], o2[2];
#pragma unroll
                    for (int n = 0; n < 2; ++n) { const f32x4 c = *(const f32x4*)(cs + (size_t)row * 32 + 8 * fq + 4 * n), s = *(const f32x4*)(sn + (size_t)row * 32 + 8 * fq + 4 * n);
                        const f32x4 x1 = acc[ai][0][m][n], x2 = acc[ai][1][m][n]; o1[n] = x1 * c - x2 * s; o2[n] = x1 * s + x2 * c; }
                    *(u32x4*)(KR + (size_t)row * 64 + 8 * fq) = pack8(o1[0], o1[1]); *(u32x4*)(KR + (size_t)row * 64 + 32 + 8 * fq) = pack8(o2[0], o2[1]); }
        }
    }
};
struct EpiQ {
    static constexpr bool PERM = true, AFTER_DRAIN = false;
    bf16_t* Q; const float* ssq; const float* cs; const float* sn; float qscale;
    __device__ __forceinline__ void operator()(const f32x4 (&acc)[2][2][4][2], const Unit& u, int wr, int wc, int fr, int fq) const {
        const int row0 = u.pm * BM + wr * 64 + fr;
#pragma unroll
        for (int ai = 0; ai < 2; ++ai)
#pragma unroll
            for (int m = 0; m < 4; ++m) { const int row = row0 + ai * HALF + m * 16;
                const f32x4 p0 = *(const f32x4*)(ssq + (size_t)row * 16), p1 = *(const f32x4*)(ssq + (size_t)row * 16 + 4);
                const float rs = qscale / sqrtf(((p0[0] + p0[1]) + (p0[2] + p0[3]) + (p1[0] + p1[1]) + (p1[2] + p1[3])) * (1.0f / QLORA) + LN_EPS);
                if (u.pn < 4) {
#pragma unroll
                    for (int bj = 0; bj < 2; ++bj) *(u32x4*)(Q + (size_t)row * QLD + (2 * u.pn + bj) * QKD + wc * 32 + 8 * fq) = pack8(acc[ai][bj][m][0] * rs, acc[ai][bj][m][1] * rs);
                } else { const int head = 4 * (u.pn - 4) + wc; f32x4 o1[2], o2[2];
#pragma unroll
                    for (int n = 0; n < 2; ++n) { const f32x4 c = *(const f32x4*)(cs + (size_t)row * 32 + 8 * fq + 4 * n), s = *(const f32x4*)(sn + (size_t)row * 32 + 8 * fq + 4 * n);
                        const f32x4 x1 = acc[ai][0][m][n] * rs, x2 = acc[ai][1][m][n] * rs; o1[n] = x1 * c - x2 * s; o2[n] = x1 * s + x2 * c; }
                    bf16_t* qp = Q + (size_t)row * QLD + head * QKD + NOPE + 8 * fq;
                    *(u32x4*)qp = pack8(o1[0], o1[1]); *(u32x4*)(qp + 32) = pack8(o2[0], o2[1]); } }
    }
};
struct EpiKV {
    static constexpr bool PERM = true, AFTER_DRAIN = false;
    bf16_t* Kb; bf16_t* Vb; const float* ssq;
    __device__ __forceinline__ void operator()(const f32x4 (&acc)[2][2][4][2], const Unit& u, int wr, int wc, int fr, int fq) const {
        const int row0 = u.pm * BM + wr * 64 + fr;
#pragma unroll
        for (int ai = 0; ai < 2; ++ai)
#pragma unroll
            for (int m = 0; m < 4; ++m) { const int row = row0 + ai * HALF + m * 16;
                const f32x4 p0 = *(const f32x4*)(ssq + (size_t)row * 16 + 8), p1 = *(const f32x4*)(ssq + (size_t)row * 16 + 12);
                const float rs = 1.0f / sqrtf(((p0[0] + p0[1]) + (p0[2] + p0[3]) + (p1[0] + p1[1]) + (p1[2] + p1[3])) * (1.0f / KVLORA) + LN_EPS);
                const size_t o = (size_t)row * KLD + u.pn * NOPE + wc * 32 + 8 * fq;
                *(u32x4*)(Kb + o) = pack8(acc[ai][0][m][0] * rs, acc[ai][0][m][1] * rs);
                *(u32x4*)(Vb + o) = pack8(acc[ai][1][m][0] * rs, acc[ai][1][m][1] * rs); }
    }
};

template <class Epi, class Sched>
__device__ __forceinline__ void gemm_ref(const Gemm g, const Sched& S, const Epi& E) {
    const int tid = opaque_tid(), wid = __builtin_amdgcn_readfirstlane(tid >> 6), lane = tid & 63, wr = wid >> 2, wc = wid & 3, fr = lane & 15, fq = lane >> 4;
    Unit u;
    for (int i = 0; S.next(i, u); ++i) {
        f32x4 acc[2][2][4][2];
#pragma unroll
        for (int a = 0; a < 2; ++a)
#pragma unroll
            for (int b = 0; b < 2; ++b)
#pragma unroll
                for (int m = 0; m < 4; ++m)
#pragma unroll
                    for (int n = 0; n < 2; ++n) acc[a][b][m][n] = (f32x4){0.f, 0.f, 0.f, 0.f};
        const bf16_t* Ab = g.A + (size_t)(u.pm * BM + wr * 64 + fr) * g.lda + fq * 8;
        const bf16_t* Bb = g.Bt + (size_t)(u.pn * BM + wc * 32) * g.ldb + fq * 8;
        const int rb0 = Epi::PERM ? perm32(fr) : fr, rb1 = Epi::PERM ? perm32(16 + fr) : 16 + fr;
        for (int k = 0; k < g.K; k += 32) {
            bf16x8 a[2][4], b[2][2];
#pragma unroll
            for (int ai = 0; ai < 2; ++ai)
#pragma unroll
                for (int m = 0; m < 4; ++m) a[ai][m] = *(const bf16x8*)(Ab + (size_t)(ai * HALF + m * 16) * g.lda + k);
#pragma unroll
            for (int bj = 0; bj < 2; ++bj) { b[bj][0] = *(const bf16x8*)(Bb + (size_t)(bj * HALF + rb0) * g.ldb + k); b[bj][1] = *(const bf16x8*)(Bb + (size_t)(bj * HALF + rb1) * g.ldb + k); }
#pragma unroll
            for (int ai = 0; ai < 2; ++ai)
#pragma unroll
                for (int bj = 0; bj < 2; ++bj)
#pragma unroll
                    for (int m = 0; m < 4; ++m)
#pragma unroll
                        for (int n = 0; n < 2; ++n) acc[ai][bj][m][n] = __builtin_amdgcn_mfma_f32_16x16x32_bf16(b[bj][n], a[ai][m], acc[ai][bj][m][n], 0, 0, 0);
        }
        E(acc, u, wr, wc, fr, fq);
    }
}
template <class Epi, class Sched, bool ALIGN_EPI = false, bool SP2 = false>
__device__ __forceinline__ void gemm_phase(PG8_LAS unsigned char* lds, const Gemm g, const Sched& S, const Epi& E) {
    const int tid = opaque_tid(), wid = __builtin_amdgcn_readfirstlane(tid >> 6), lane = tid & 63, wr = wid >> 2, wc = wid & 3, fr = lane & 15, fq = lane >> 4;
    const int K = g.K, nt = K / BK;
    unsigned voffA[2], voffB[2];
#pragma unroll
    for (int i = 0; i < 2; ++i) { int R, C; stage_rc(tid * 16 + i * 8192, R, C); const int Rb = Epi::PERM ? ((R & ~31) + perm32(R & 31)) : R;
        voffA[i] = (unsigned)(R * g.lda + C) * 2u; voffB[i] = (unsigned)(Rb * g.ldb + C) * 2u; }
    const size_t kstep = (size_t)(BK * 2);
    const size_t hstepA = (size_t)HALF * g.lda * 2, hstepB = (size_t)HALF * g.ldb * 2;
    const size_t tstepA = 2 * hstepA, tstepB = 2 * hstepB;
    const unsigned ldsw = (unsigned)wid * 1024u;
    const int aoff = lds_byte(wr * 64 + fr, fq * 8), boff = lds_byte(wc * 32 + fr, fq * 8);
#define PG8_SA(b, h) (((b) * 2 + (h)) * HTB)
#define PG8_SB(b, h) ((4 + (b) * 2 + (h)) * HTB)
#define PG8_STAGE(bufoff, gbase, voff) do { _Pragma("unroll") for (int _i = 0; _i < 2; ++_i) \
        __builtin_amdgcn_global_load_lds((const unsigned*)((const char*)(gbase) + (voff)[_i]), (PG8_LAS unsigned*)(lds + (bufoff) + ldsw + _i * 8192), 16, 0, 0); } while (0)
#define PG8_LDA(dst, b, h) do { _Pragma("unroll") for (int m = 0; m < 4; ++m) _Pragma("unroll") for (int k = 0; k < 2; ++k) dst[m][k] = *(const PG8_LAS bf16x8*)(lds + PG8_SA(b, h) + aoff + m * 2048 + k * 1024); } while (0)
#define PG8_LDB(dst, b, h) do { _Pragma("unroll") for (int n = 0; n < 2; ++n) _Pragma("unroll") for (int k = 0; k < 2; ++k) dst[n][k] = *(const PG8_LAS bf16x8*)(lds + PG8_SB(b, h) + boff + n * 2048 + k * 1024); } while (0)
#define PG8_MMA(ai, bj, At, Bt) do { __builtin_amdgcn_s_setprio(1); _Pragma("unroll") for (int m = 0; m < 4; ++m) _Pragma("unroll") for (int n = 0; n < 2; ++n) _Pragma("unroll") for (int k = 0; k < 2; ++k) \
        acc[ai][bj][m][n] = __builtin_amdgcn_mfma_f32_16x16x32_bf16(Bt[n][k], At[m][k], acc[ai][bj][m][n], 0, 0, 0); __builtin_amdgcn_s_setprio(0); } while (0)
#define PG8_WAIT_V(n) asm volatile("s_waitcnt vmcnt(" #n ")" ::: "memory")
#define PG8_WAIT_L(n) asm volatile("s_waitcnt lgkmcnt(" #n ")" ::: "memory")
#define PG8_BAR __builtin_amdgcn_s_barrier()
#define PG8_SCHED __builtin_amdgcn_sched_barrier(0)
    Unit cur, nxt; int ui = 0;
    if (!S.next(0, cur)) return;
    f32x4 acc[2][2][4][2];
#pragma unroll
    for (int a = 0; a < 2; ++a)
#pragma unroll
        for (int b = 0; b < 2; ++b)
#pragma unroll
            for (int m = 0; m < 4; ++m)
#pragma unroll
                for (int n = 0; n < 2; ++n) acc[a][b][m][n] = (f32x4){0.f, 0.f, 0.f, 0.f};
    bf16x8 At[4][2], B0[2][2], B1[2][2];
    const char* cA = (const char*)g.A + (size_t)cur.pm * tstepA; const char* cB = (const char*)g.Bt + (size_t)cur.pn * tstepB;
    S.a_ready(cur);
    if constexpr (SP2) {
        PG8_STAGE(PG8_SB(0, 0), cB, voffB); PG8_STAGE(PG8_SB(0, 1), cB + hstepB, voffB); PG8_STAGE(PG8_SA(0, 0), cA, voffA); PG8_STAGE(PG8_SA(0, 1), cA + hstepA, voffA);
        if (wr == 1) PG8_BAR;
        PG8_WAIT_V(2); PG8_BAR;
        PG8_STAGE(PG8_SB(1, 0), cB + kstep, voffB); PG8_STAGE(PG8_SA(1, 0), cA + kstep, voffA); PG8_STAGE(PG8_SB(1, 1), cB + hstepB + kstep, voffB);
        PG8_WAIT_V(6); PG8_BAR;
    } else {
        PG8_STAGE(PG8_SB(0, 0), cB, voffB); PG8_STAGE(PG8_SA(0, 0), cA, voffA); PG8_STAGE(PG8_SB(0, 1), cB + hstepB, voffB); PG8_STAGE(PG8_SA(0, 1), cA + hstepA, voffA);
        if (wr == 1) PG8_BAR;
        PG8_WAIT_V(4); PG8_BAR;
        PG8_STAGE(PG8_SB(1, 0), cB + kstep, voffB); PG8_STAGE(PG8_SA(1, 0), cA + kstep, voffA); PG8_STAGE(PG8_SB(1, 1), cB + hstepB + kstep, voffB);
        PG8_WAIT_V(6); PG8_BAR;
    }
    for (;;) {
        const bool has_next = S.next(ui + 1, nxt);
        const char* nA = has_next ? (const char*)g.A + (size_t)nxt.pm * tstepA : cA; const char* nB = has_next ? (const char*)g.Bt + (size_t)nxt.pn * tstepB : cB;
        for (int t = 0; t < nt; t += 2) {
            const bool last = (t == nt - 2);
            const char* a1 = cA + (size_t)(t + 1) * kstep;
            const char* a2 = last ? nA : cA + (size_t)(t + 2) * kstep; const char* b2 = last ? nB : cB + (size_t)(t + 2) * kstep;
            const char* a3 = a2 + kstep; const char* b3 = b2 + kstep;
            if (last && has_next) S.a_ready(nxt);
            if constexpr (SP2) {
            PG8_LDB(B0, 0, 0); PG8_LDB(B1, 0, 1); PG8_SCHED; PG8_LDA(At, 0, 0); PG8_STAGE(PG8_SA(1, 1), a1 + hstepA, voffA);
            PG8_WAIT_V(8); PG8_WAIT_L(0); PG8_BAR; PG8_MMA(0, 0, At, B0); PG8_MMA(0, 1, At, B1); PG8_BAR; PG8_SCHED;
            PG8_LDA(At, 0, 1); PG8_STAGE(PG8_SB(0, 0), b2, voffB); PG8_STAGE(PG8_SB(0, 1), b2 + hstepB, voffB); PG8_STAGE(PG8_SA(0, 0), a2, voffA);
            PG8_WAIT_V(8); PG8_WAIT_L(0); PG8_BAR; PG8_MMA(1, 0, At, B0); PG8_MMA(1, 1, At, B1); PG8_BAR; PG8_SCHED;
            PG8_LDB(B0, 1, 0); PG8_LDB(B1, 1, 1); PG8_SCHED; PG8_LDA(At, 1, 0); PG8_STAGE(PG8_SA(0, 1), a2 + hstepA, voffA);
            PG8_WAIT_V(8); PG8_WAIT_L(0); PG8_BAR; PG8_MMA(0, 0, At, B0); PG8_MMA(0, 1, At, B1); PG8_BAR; PG8_SCHED;
            PG8_LDA(At, 1, 1); PG8_STAGE(PG8_SB(1, 0), b3, voffB); PG8_STAGE(PG8_SB(1, 1), b3 + hstepB, voffB); PG8_STAGE(PG8_SA(1, 0), a3, voffA);
            PG8_WAIT_V(8); PG8_WAIT_L(0); PG8_BAR; PG8_MMA(1, 0, At, B0); PG8_MMA(1, 1, At, B1); PG8_BAR; PG8_SCHED;
            } else {
            PG8_LDB(B0, 0, 0); PG8_SCHED; PG8_LDA(At, 0, 0); PG8_STAGE(PG8_SA(1, 1), a1 + hstepA, voffA);
            PG8_WAIT_L(8); PG8_BAR; PG8_WAIT_L(0); PG8_MMA(0, 0, At, B0); PG8_BAR; PG8_SCHED;
            PG8_LDB(B1, 0, 1); PG8_STAGE(PG8_SB(0, 0), b2, voffB);
            PG8_BAR; PG8_WAIT_L(0); PG8_MMA(0, 1, At, B1); PG8_BAR;
            PG8_LDA(At, 0, 1); PG8_STAGE(PG8_SA(0, 0), a2, voffA);
            PG8_BAR; PG8_WAIT_L(0); PG8_MMA(1, 0, At, B0); PG8_BAR; PG8_SCHED;
            PG8_STAGE(PG8_SB(0, 1), b2 + hstepB, voffB);
            PG8_WAIT_V(6); PG8_BAR; PG8_MMA(1, 1, At, B1); PG8_BAR;
            PG8_LDB(B0, 1, 0); PG8_SCHED; PG8_LDA(At, 1, 0); PG8_STAGE(PG8_SA(0, 1), a2 + hstepA, voffA);
            PG8_WAIT_L(8); PG8_BAR; PG8_WAIT_L(0); PG8_MMA(0, 0, At, B0); PG8_BAR; PG8_SCHED;
            PG8_LDB(B1, 1, 1); PG8_STAGE(PG8_SB(1, 0), b3, voffB);
            PG8_BAR; PG8_WAIT_L(0); PG8_MMA(0, 1, At, B1); PG8_BAR;
            PG8_LDA(At, 1, 1); PG8_STAGE(PG8_SA(1, 0), a3, voffA);
            PG8_BAR; PG8_WAIT_L(0); PG8_MMA(1, 0, At, B0); PG8_BAR; PG8_SCHED;
            PG8_STAGE(PG8_SB(1, 1), b3 + hstepB, voffB);
            PG8_WAIT_V(6); PG8_BAR; PG8_MMA(1, 1, At, B1); PG8_BAR;
            }
        }
        if constexpr (ALIGN_EPI) { if (wr == 0) PG8_BAR; }
        if constexpr (!Epi::AFTER_DRAIN) { E(acc, cur, wr, wc, fr, fq); S.done(cur); }
        if (!has_next) break;
#pragma unroll
        for (int a = 0; a < 2; ++a)
#pragma unroll
            for (int b = 0; b < 2; ++b)
#pragma unroll
                for (int m = 0; m < 4; ++m)
#pragma unroll
                    for (int n = 0; n < 2; ++n) acc[a][b][m][n] = (f32x4){0.f, 0.f, 0.f, 0.f};
        cur = nxt; cA = nA; cB = nB; ++ui;
        if constexpr (ALIGN_EPI) { if (wr == 1) PG8_BAR; }
    }
    PG8_WAIT_V(0);
    if constexpr (!ALIGN_EPI) { if (wr == 0) PG8_BAR; }
    PG8_BAR;
    if constexpr (Epi::AFTER_DRAIN) { E.fused(acc, cur, wr, wc, fr, fq, lds, wid, lane); S.done(cur); }
#undef PG8_SA
#undef PG8_SB
#undef PG8_STAGE
#undef PG8_LDA
#undef PG8_LDB
#undef PG8_MMA
#undef PG8_WAIT_V
#undef PG8_WAIT_L
#undef PG8_BAR
#undef PG8_SCHED
}
}

#define RLX_AGENT __ATOMIC_RELAXED, __HIP_MEMORY_SCOPE_AGENT
#define LDS_WAIT() asm volatile("s_waitcnt lgkmcnt(0)" ::: "memory")
#define VM_WAIT() asm volatile("s_waitcnt vmcnt(0)" ::: "memory")
#define XB_TMO      128
#define XB_XCNT(j)  (256  + 64 * (j))
#define XB_XSUB(j)  (1280 + 64 * (j))
#define XB_XGEN(j)  (2304 + 64 * (j))
#define XB_TOP      3328
#define XB_TOPGEN   3392
#define XCD_BAR_WORDS 3456
#define XB_SPIN_CAP (1u << 25)

__device__ __forceinline__ unsigned xb_ld(unsigned* p)              { return __hip_atomic_load(p, __ATOMIC_RELAXED, __HIP_MEMORY_SCOPE_AGENT); }
__device__ __forceinline__ unsigned xb_add(unsigned* p, unsigned v) { return __hip_atomic_fetch_add(p, v, __ATOMIC_RELAXED, __HIP_MEMORY_SCOPE_AGENT); }
__device__ __forceinline__ unsigned xb_xcc_id() { return (unsigned)__builtin_amdgcn_s_getreg((3 << 11) | 20) & 0xFu; }
#define XB_SPIN(cond, bar) do { unsigned _sp = 0; while (cond) { __builtin_amdgcn_s_sleep(1); \
    if ((++_sp & 255u) == 0u) { if (xb_ld(&(bar)[XB_TMO])) break; if (_sp > XB_SPIN_CAP) { atomicAdd(&(bar)[XB_TMO], 1u); break; } } } } while (0)

struct XcdBarrier {
    unsigned* bar; unsigned x;
    volatile LAS unsigned* st;
};

__device__ __forceinline__ XcdBarrier xcd_barrier_post(unsigned* bar, volatile LAS unsigned* st) {
    XcdBarrier b; b.bar = bar; b.x = xb_xcc_id(); b.st = st;
    if (threadIdx.x == 0) (void)xb_add(&bar[XB_XCNT(b.x)], 1u);
    return b;
}
__device__ __forceinline__ void xcd_barrier_complete(unsigned* bar, unsigned x, unsigned& nloc, unsigned& nx) {
    const unsigned G = gridDim.x * gridDim.y * gridDim.z;
    unsigned sum, cnt, mine, sp = 0u;
    for (;;) {
        sum = 0u; cnt = 0u; mine = 0u;
#pragma unroll
        for (unsigned j = 0; j < 16; ++j) { const unsigned c = xb_ld(&bar[XB_XCNT(j)]); sum += c; cnt += (c > 0u) ? 1u : 0u; mine = (j == x) ? c : mine; }
        if (sum == G) break;
        __builtin_amdgcn_s_sleep(1);
        if ((++sp & 255u) == 0u) { if (xb_ld(&bar[XB_TMO])) break; if (sp > XB_SPIN_CAP) { atomicAdd(&bar[XB_TMO], 1u); break; } }
    }
    nloc = mine > 0u ? mine : 1u; nx = cnt > 0u ? cnt : 1u;
}

__device__ __forceinline__ void xcd_barrier(const XcdBarrier& b) {
    asm volatile("s_waitcnt vmcnt(0)" ::: "memory");
    __syncthreads();
    if (threadIdx.x == 0) {
        unsigned* bar = b.bar;
        __builtin_amdgcn_s_waitcnt(0);
        unsigned nloc = b.st[0], nx = b.st[1];
        if (nloc == 0u) { xcd_barrier_complete(bar, b.x, nloc, nx); b.st[0] = nloc; b.st[1] = nx; }
        const unsigned old = xb_add(&bar[XB_XSUB(b.x)], 1u);
        const unsigned gen = old / nloc;
        if (old + 1u == (gen + 1u) * nloc) {
            __builtin_amdgcn_fence(__ATOMIC_RELEASE, "agent");
            asm volatile("s_waitcnt vmcnt(0)" ::: "memory");
            const unsigned og = xb_add(&bar[XB_TOP], 1u);
            const unsigned tg = og / nx;
            if (og + 1u == (tg + 1u) * nx) xb_add(&bar[XB_TOPGEN], 1u);
            else XB_SPIN(xb_ld(&bar[XB_TOPGEN]) == tg, bar);
            __builtin_amdgcn_fence(__ATOMIC_ACQUIRE, "agent");
            xb_add(&bar[XB_XGEN(b.x)], 1u);
            asm volatile("s_waitcnt vmcnt(0)" ::: "memory");
        } else {
            XB_SPIN(xb_ld(&bar[XB_XGEN(b.x)]) == gen, bar);
            __builtin_amdgcn_fence(__ATOMIC_ACQUIRE, "agent");
            asm volatile("s_waitcnt vmcnt(0)" ::: "memory");
        }
    }
    __syncthreads();
}
struct Args { const void* in[27]; float* out; unsigned char* ws; };
#define INF(i) ((const float*)args.in[i])
#define WSP(T, off) ((T*)(F.ws + (off)))
constexpr int NWAVES = 8;
constexpr int RING_OFF = 0, RING_BYTES = 131072;
constexpr int LDSCTL_OFF = RING_BYTES, MISC_OFF = LDSCTL_OFF + 320;
constexpr int LDS_BYTES = 147456;
static_assert(MISC_OFF + 128 <= LDS_BYTES, "LDS map");

struct Frame {
    LAS unsigned char* lds;
    volatile LAS unsigned* MISC;
    gu32* ctl;
    int tid, lane, wave, vcu, G;
    unsigned char* ws; float* out;
};

__device__ __forceinline__ int t5_bucket(int n) {
    if (n < 16) return n;
    const int b = 16 + (int)(__logf((float)n * (1.0f / 16.0f)) * (16.0f / 2.0794415416798357f));
    return b < 31 ? b : 31;
}

__device__ __forceinline__ void tr_item(const float* W, int ldw, int k0, int c0, const float* gain, bf16_t* WT, int ldt, int r0, LAS float* scr, int lane) {
    if (c0 >= 0) {
#pragma unroll 8
        for (int i = 0; i < 32; ++i) { const int kk = 2 * i + (lane >> 5); float v = W[(size_t)(k0 + kk) * ldw + c0 + (lane & 31)]; if (gain) v *= gain[k0 + kk]; scr[kk * 33 + (lane & 31)] = v; }
    } else {
#pragma unroll 8
        for (int i = 0; i < 32; ++i) { const int kk = 2 * i + (lane >> 5); scr[kk * 33 + (lane & 31)] = 0.f; }
    }
    LDS_WAIT(); asm volatile("" ::: "memory");
    const int c = lane & 7;
#pragma unroll
    for (int j = 0; j < 4; ++j) { const int n = (lane >> 3) + 8 * j; const LAS float* s = scr + (8 * c) * 33 + n;
        u32x4 o; o.x = pk2(s[0 * 33], s[1 * 33]); o.y = pk2(s[2 * 33], s[3 * 33]); o.z = pk2(s[4 * 33], s[5 * 33]); o.w = pk2(s[6 * 33], s[7 * 33]);
        *(u32x4*)(WT + (size_t)(r0 + n) * ldt + k0 + 8 * c) = o; }
    LDS_WAIT(); asm volatile("" ::: "memory");
}
__device__ __forceinline__ void sincos_d(double a, float& s, float& c) {
    const double q = __builtin_rint(a * 0.6366197723675814);
    double r = __builtin_fma(-q, 1.5707963267948966, a); r = __builtin_fma(-q, 6.123233995736766e-17, r);
    const double r2 = r * r;
    double sp = 1.0 / 6227020800.0; sp = sp * r2 - 1.0 / 39916800.0; sp = sp * r2 + 1.0 / 362880.0; sp = sp * r2 - 1.0 / 5040.0; sp = sp * r2 + 1.0 / 120.0; sp = sp * r2 - 1.0 / 6.0; sp = sp * r2 + 1.0; sp *= r;
    double cp = -1.0 / 87178291200.0; cp = cp * r2 + 1.0 / 479001600.0; cp = cp * r2 - 1.0 / 3628800.0; cp = cp * r2 + 1.0 / 40320.0; cp = cp * r2 - 1.0 / 720.0; cp = cp * r2 + 1.0 / 24.0; cp = cp * r2 - 0.5; cp = cp * r2 + 1.0;
    const int qi = (int)q & 3;
    const double ss = (qi == 0) ? sp : (qi == 1) ? cp : (qi == 2) ? -sp : -cp;
    const double cc = (qi == 0) ? cp : (qi == 1) ? -sp : (qi == 2) ? -cp : sp;
    s = (float)ss; c = (float)cc;
}
__device__ __forceinline__ void p0_prologue(Frame& F, const Args& args) {
    LAS float* scr = (LAS float*)(F.lds + RING_OFF + F.wave * 16384);
    const int gw = F.vcu * NWAVES + F.wave, NGW = F.G * NWAVES;
    constexpr int I13 = (D / 64) * (2 * FF / 32), I2 = (FF / 64) * (D / 32), IIN = (D / 64) * (ZLD / 32), IUQ = (QLORA / 64) * (QLD / 32), IUKV = (KVLORA / 64) * (2 * KLD / 32),
                  IOUT = (D / 64) * (D / 32), IG = IOUT, IPLE = (PLE / 64) * (D / 32);
    constexpr int NITEMS = 2 * I13 + 2 * I2 + IIN + IUQ + IUKV + IOUT + IG + IPLE;
    for (int it = gw; it < NITEMS; it += NGW) {
        int r = it;
        if (r < 2 * I13) {
            const bool second = r >= I13; if (second) r -= I13;
            const int nblk = 2 * FF / 32, kb = r / nblk, nb = r % nblk, j = nb >> 3, w = nb & 7, b = w >> 2, i0 = (w & 3) * 32;
            const float* src = INF(second ? (b ? 21 : 20) : (b ? 7 : 6));
            tr_item(src, FF, 64 * kb, 128 * j + i0, nullptr, WSP(bf16_t, second ? WS_W13B : WS_W13A), D, 32 * nb, scr, F.lane); continue; }
        r -= 2 * I13;
        if (r < 2 * I2) { const bool second = r >= I2; if (second) r -= I2;
            const int nblk = D / 32, kb = r / nblk, nb = r % nblk;
            tr_item(INF(second ? 22 : 8), D, 64 * kb, 32 * nb, nullptr, WSP(bf16_t, second ? WS_W2B : WS_W2A), FF, 32 * nb, scr, F.lane); continue; }
        r -= 2 * I2;
        if (r < IIN) { const int nblk = ZLD / 32, kb = r / nblk, nb = r % nblk, r0 = 32 * nb;
            int c0;
            if (r0 < 1024) c0 = r0; else if (r0 < 2048) c0 = 1088 + (r0 - 1024); else if (r0 < 2304) c0 = 2112 + (r0 - 2048); else if (r0 == 2304) c0 = 1024; else if (r0 == 2432) c0 = 1056; else c0 = -1;
            tr_item(INF(9), DIN, 64 * kb, c0, nullptr, WSP(bf16_t, WS_WIN), D, r0, scr, F.lane); continue; }
        r -= IIN;
        if (r < IUQ) { const int nblk = QLD / 32, kb = r / nblk, nb = r % nblk, r0 = 32 * nb;
            int c0;
            if (r0 < 1024) c0 = QKD * (r0 >> 7) + (r0 & 127);
            else { const int t = (r0 - 1024) >> 8, b = ((r0 - 1024) >> 7) & 1, w = (r0 & 127) >> 5; c0 = QKD * (4 * t + w) + NOPE + 32 * b; }
            tr_item(INF(11), QLD, 64 * kb, c0, INF(10), WSP(bf16_t, WS_WUQ), QLORA, r0, scr, F.lane); continue; }
        r -= IUQ;
        if (r < IUKV) { const int nblk = 2 * KLD / 32, kb = r / nblk, nb = r % nblk;
            tr_item(INF(13), 2 * KLD, 64 * kb, 32 * nb, INF(12), WSP(bf16_t, WS_WUKV), KVLORA, 32 * nb, scr, F.lane); continue; }
        r -= IUKV;
        if (r < IOUT) { const int nblk = D / 32, kb = r / nblk, nb = r % nblk, k0 = 64 * kb;
            tr_item(INF(17), D, k0, 32 * nb, k0 < 1024 ? INF(15) : INF(16) - 1024, WSP(bf16_t, WS_WOUT), D, 32 * nb, scr, F.lane); continue; }
        r -= IOUT;
        if (r < IG) { const int nblk = D / 32, kb = r / nblk, nb = r % nblk;
            tr_item(INF(25), D, 64 * kb, 32 * nb, nullptr, WSP(bf16_t, WS_WG), D, 32 * nb, scr, F.lane); continue; }
        r -= IG;
        { const int nblk = D / 32, kb = r / nblk, nb = r % nblk;
            tr_item(INF(26), D, 64 * kb, 32 * nb, nullptr, WSP(bf16_t, WS_WPLE), PLE, 32 * nb, scr, F.lane); }
    }
    const int gt = F.vcu * (NWAVES * 64) + F.tid, NGT = F.G * NWAVES * 64;
    for (int i = gt; i < M * D / 8; i += NGT) { const f32x4 a = ((const f32x4*)INF(0))[2 * i], b = ((const f32x4*)INF(0))[2 * i + 1];
        u32x4 o; o.x = pk2(a[0], a[1]); o.y = pk2(a[2], a[3]); o.z = pk2(b[0], b[1]); o.w = pk2(b[2], b[3]); ((u32x4*)WSP(bf16_t, WS_HB))[i] = o; }
    for (int i = gt; i < M * PLE / 8; i += NGT) { const f32x4 a = ((const f32x4*)INF(1))[2 * i], b = ((const f32x4*)INF(1))[2 * i + 1];
        u32x4 o; o.x = pk2(a[0], a[1]); o.y = pk2(a[2], a[3]); o.z = pk2(b[0], b[1]); o.w = pk2(b[2], b[3]); ((u32x4*)WSP(bf16_t, WS_PB))[i] = o; }
    for (int i = gt; i < M * 32; i += NGT) { const int row = i >> 5, fi = i & 31; double fr = 1.0; for (int k = 0; k < fi; ++k) fr *= 0.7498942093324559;
        float s, c; sincos_d((double)((const int*)args.in[2])[row] * fr, s, c); WSP(float, WS_COS)[i] = c; WSP(float, WS_SIN)[i] = s; }
    for (int i = gt; i < SWH * WINDOW; i += NGT) { const int h = i >> 7, dist = i & 127; WSP(float, WS_BIAS)[i] = INF(3)[t5_bucket(dist) * SWH + h] * LOG2E; }
}

__device__ __forceinline__ void ln_pass(Frame& F, float* io, const float* g, const float* b, bf16_t* hb) {
    const int gw = F.vcu * NWAVES + F.wave, NGW = F.G * NWAVES;
    for (int m = gw; m < M; m += NGW) {
        f32x4* xr = (f32x4*)(io + (size_t)m * D) + F.lane;
        f32x4 v[8]; float s = 0.f;
#pragma unroll
        for (int j = 0; j < 8; ++j) { v[j] = xr[64 * j]; s += (v[j][0] + v[j][1]) + (v[j][2] + v[j][3]); }
        const float mean = wave_sum(s) * (1.0f / D); float s2 = 0.f;
#pragma unroll
        for (int j = 0; j < 8; ++j) { v[j] = v[j] - mean; s2 += (v[j][0] * v[j][0] + v[j][1] * v[j][1]) + (v[j][2] * v[j][2] + v[j][3] * v[j][3]); }
        const float rstd = 1.0f / sqrtf(wave_sum(s2) * (1.0f / D) + LN_EPS);
        u32x2* o8 = (u32x2*)(hb + (size_t)m * D) + F.lane;
#pragma unroll
        for (int j = 0; j < 8; ++j) { const f32x4 gg = ((const f32x4*)g)[F.lane + 64 * j], bb = ((const f32x4*)b)[F.lane + 64 * j]; const f32x4 o = v[j] * rstd * gg + bb;
            xr[64 * j] = o; u32x2 w; w.x = pk2(o[0], o[1]); w.y = pk2(o[2], o[3]); o8[64 * j] = w; }
    }
}
__device__ __forceinline__ void norm_mix_pass(Frame& F) {
    const int gw = F.vcu * NWAVES + F.wave, NGW = F.G * NWAVES;
    for (int m = gw; m < M; m += NGW) {
        u32x4* ar = (u32x4*)(WSP(bf16_t, WS_AMIX) + (size_t)m * D) + F.lane;
        float v[4][8]; float s[2] = {0.f, 0.f};
#pragma unroll
        for (int j = 0; j < 4; ++j) { const u32x4 w = ar[64 * j];
#pragma unroll
            for (int e = 0; e < 4; ++e) { v[j][2 * e] = __uint_as_float(w[e] << 16); v[j][2 * e + 1] = __uint_as_float(w[e] & 0xffff0000u); }
#pragma unroll
            for (int e = 0; e < 8; ++e) s[j >> 1] += v[j][e] * v[j][e]; }
        const float r0 = 1.0f / sqrtf(wave_sum(s[0]) * (1.0f / 1024.0f) + LN_EPS), r1 = 1.0f / sqrtf(wave_sum(s[1]) * (1.0f / 1024.0f) + LN_EPS);
#pragma unroll
        for (int j = 0; j < 4; ++j) { const float r = (j < 2) ? r0 : r1; u32x4 w;
#pragma unroll
            for (int e = 0; e < 4; ++e) w[e] = pk2(v[j][2 * e] * r, v[j][2 * e + 1] * r);
            ar[64 * j] = w; }
    }
}

__device__ __forceinline__ void mla_attn_naive(Frame& F) {
    LAS float* qs = (LAS float*)(F.lds + F.wave * 8192); LAS float* sc = qs + 256;
    const int gw = F.vcu * NWAVES + F.wave, NGW = F.G * NWAVES, lane = F.lane;
    for (int task = gw; task < M * NH; task += NGW) {
        const int head = task & 7, q = task >> 3;
        const bf16_t* qp = WSP(bf16_t, WS_Q) + (size_t)q * QLD + head * QKD;
        asm volatile("" ::: "memory");
#pragma unroll
        for (int j = 0; j < 3; ++j) qs[lane + 64 * j] = bf2f(qp[lane + 64 * j]);
        LDS_WAIT(); asm volatile("" ::: "memory");
        float m = -INFINITY, l = 0.f, a0 = 0.f, a1 = 0.f;
        for (int c0 = 0; c0 <= q; c0 += 1024) {
            const int nk = (q + 1 - c0) < 1024 ? (q + 1 - c0) : 1024;
            float cmax = -INFINITY;
            for (int kk = lane; kk < nk; kk += 64) {
                const int key = c0 + kk;
                const bf16_t* kp = WSP(bf16_t, WS_K) + (size_t)key * KLD + head * NOPE; const bf16_t* rp = WSP(bf16_t, WS_KR) + (size_t)key * 64;
                float s = 0.f;
                for (int c = 0; c < 16; ++c) { const bf16x8 kv = *(const bf16x8*)(kp + 8 * c);
#pragma unroll
                    for (int e = 0; e < 8; ++e) s += qs[8 * c + e] * bf2f((bf16_t)kv[e]); }
                for (int c = 0; c < 8; ++c) { const bf16x8 kv = *(const bf16x8*)(rp + 8 * c);
#pragma unroll
                    for (int e = 0; e < 8; ++e) s += qs[NOPE + 8 * c + e] * bf2f((bf16_t)kv[e]); }
                sc[kk] = s; cmax = fmaxf(cmax, s);
            }
            cmax = wave_max(cmax);
            const float mn = fmaxf(m, cmax), f = exp2f(m - mn);
            l *= f; a0 *= f; a1 *= f; m = mn;
            float ps = 0.f;
            for (int kk = lane; kk < nk; kk += 64) { const float pv = exp2f(sc[kk] - mn); sc[kk] = pv; ps += pv; }
            l += wave_sum(ps);
            LDS_WAIT(); asm volatile("" ::: "memory");
            const bf16_t* vp = WSP(bf16_t, WS_V) + (size_t)c0 * KLD + head * VD + 2 * lane;
            int kk = 0;
            for (; kk + 8 <= nk; kk += 8) { unsigned vv[8];
#pragma unroll
                for (int e = 0; e < 8; ++e) vv[e] = *(const unsigned*)(vp + (size_t)(kk + e) * KLD);
#pragma unroll
                for (int e = 0; e < 8; ++e) { const float pv = sc[kk + e]; a0 += pv * __uint_as_float(vv[e] << 16); a1 += pv * __uint_as_float(vv[e] & 0xffff0000u); } }
            for (; kk < nk; ++kk) { const float pv = sc[kk]; const unsigned vv = *(const unsigned*)(vp + (size_t)kk * KLD); a0 += pv * __uint_as_float(vv << 16); a1 += pv * __uint_as_float(vv & 0xffff0000u); }
            LDS_WAIT(); asm volatile("" ::: "memory");
        }
        const float il = 1.0f / l;
        *(unsigned*)(WSP(bf16_t, WS_AMIX) + (size_t)q * D + head * VD + 2 * lane) = pk2(a0 * il, a1 * il);
    }
}
__device__ __forceinline__ void swa_attn_naive(Frame& F, const Args& args) {
    LAS float* qs = (LAS float*)(F.lds + F.wave * 8192); LAS float* sc = qs + 256;
    const int gw = F.vcu * NWAVES + F.wave, NGW = F.G * NWAVES, lane = F.lane;
    for (int task = gw; task < M * SWH; task += NGW) {
        const int h = task & 15, q = task >> 4, kvh = h >> 3;
        asm volatile("" ::: "memory");
        qs[lane] = bf2f(WSP(bf16_t, WS_Z)[(size_t)q * ZLD + Z_QS + h * SWD + lane]);
        LDS_WAIT(); asm volatile("" ::: "memory");
        float sv[2];
#pragma unroll
        for (int t = 0; t < 2; ++t) { const int dist = lane + 64 * t, key = q - dist; float s = -INFINITY;
            if (key >= 0) { const bf16_t* kp = WSP(bf16_t, WS_Z) + (size_t)key * ZLD + Z_KS + kvh * SWD; float d = 0.f;
                for (int c = 0; c < 8; ++c) { const bf16x8 kv = *(const bf16x8*)(kp + 8 * c);
#pragma unroll
                    for (int e = 0; e < 8; ++e) d += qs[8 * c + e] * bf2f((bf16_t)kv[e]); }
                s = d * SWA_SCALE2 + WSP(float, WS_BIAS)[h * WINDOW + dist]; }
            sv[t] = s; }
        const float sink2 = INF(14)[h] * LOG2E;
        const float mx = fmaxf(wave_max(fmaxf(sv[0], sv[1])), sink2);
        const float e0 = exp2f(sv[0] - mx), e1 = exp2f(sv[1] - mx);
        sc[lane] = e0; sc[lane + 64] = e1;
        const float denom = wave_sum(e0 + e1) + exp2f(sink2 - mx);
        LDS_WAIT(); asm volatile("" ::: "memory");
        float acc = 0.f;
        const int nd = (q + 1) < WINDOW ? (q + 1) : WINDOW;
        int dist = 0;
        for (; dist + 8 <= nd; dist += 8) { bf16_t vv[8];
#pragma unroll
            for (int e = 0; e < 8; ++e) vv[e] = WSP(bf16_t, WS_Z)[(size_t)(q - dist - e) * ZLD + Z_VS + kvh * SWD + lane];
#pragma unroll
            for (int e = 0; e < 8; ++e) acc += sc[dist + e] * bf2f(vv[e]); }
        for (; dist < nd; ++dist) acc += sc[dist] * bf2f(WSP(bf16_t, WS_Z)[(size_t)(q - dist) * ZLD + Z_VS + kvh * SWD + lane]);
        WSP(bf16_t, WS_AMIX)[(size_t)q * D + 1024 + h * SWD + lane] = (bf16_t)f2bf(acc / denom);
        LDS_WAIT(); asm volatile("" ::: "memory");
    }
}
namespace mla {
typedef float f32x16 __attribute__((ext_vector_type(16)));
typedef short s16x4 __attribute__((ext_vector_type(4)));
typedef short v4i16_t __attribute__((ext_vector_type(4)));
constexpr int SLOT = 40960, KPART = 24576;
constexpr float THR = 8.0f;
__device__ __forceinline__ int crow(int r, int hi) { return (r & 3) + 8 * (r >> 2) + 4 * hi; }
__device__ __forceinline__ void glds16(const void* gsrc, unsigned lds_dst) { unsigned keep;
    asm volatile("s_mov_b32 %0, m0\n\ts_mov_b32 m0, %2\n\ts_nop 0\n\tglobal_load_lds_dwordx4 %1, off\n\ts_mov_b32 m0, %0" : "=&s"(keep) : "v"(gsrc), "s"(lds_dst) : "memory"); }
__device__ __forceinline__ void glds16s(const char* sbase, unsigned voff, unsigned lds_dst) { unsigned keep;
    asm volatile("s_mov_b32 %0, m0\n\ts_mov_b32 m0, %3\n\ts_nop 0\n\tglobal_load_lds_dwordx4 %1, %2\n\ts_mov_b32 m0, %0" : "=&s"(keep) : "v"(voff), "s"(sbase), "s"(lds_dst) : "memory"); }
__device__ __forceinline__ s16x4 vtr(const LAS unsigned char* p) { return __builtin_bit_cast(s16x4, __builtin_amdgcn_ds_read_tr16_b64_v4i16((LAS v4i16_t*)p)); }
__device__ __forceinline__ float swapmax(float v) { auto rr = __builtin_amdgcn_permlane32_swap(__float_as_uint(v), __float_as_uint(v), false, false); return fmaxf(__uint_as_float(rr[0]), __uint_as_float(rr[1])); }
__device__ __forceinline__ float swapsum(float v) { auto rr = __builtin_amdgcn_permlane32_swap(__float_as_uint(v), __float_as_uint(v), false, false); return __uint_as_float(rr[0]) + __uint_as_float(rr[1]); }
#define MLA_WAIT_BAR(N) asm volatile("s_waitcnt vmcnt(" #N ") lgkmcnt(0)\n\ts_barrier" ::: "memory")
#define MLA_LBAR() asm volatile("s_waitcnt lgkmcnt(0)\n\ts_barrier" ::: "memory")

__device__ __forceinline__ void unit(const bf16_t* __restrict__ Q, const bf16_t* __restrict__ K, const bf16_t* __restrict__ KR, const bf16_t* __restrict__ V, bf16_t* __restrict__ O, int head, int qb, LAS unsigned char* lds) {
    const int tid = opaque_tid(), lane = tid & 63, r32 = lane & 31, hi = lane >> 5;
    const int wid = __builtin_amdgcn_readfirstlane(tid >> 6), rg = wid & 3, kh = wid >> 2;
    const int q_rel = 32 * rg + r32, q_abs = 128 * qb + q_rel, NT = 2 * (qb + 1);
    const unsigned lds0 = (unsigned)(uintptr_t)lds;
    bf16x8 qr[12];
    { const bf16_t* qp = Q + (size_t)q_abs * QLD + head * QKD + 8 * hi;
#pragma unroll
      for (int s = 0; s < 12; ++s) qr[s] = *(const bf16x8*)(qp + 16 * s); }
#pragma unroll
    for (int s = 0; s < 12; ++s) asm volatile("" : "+v"(qr[s]));
    asm volatile("s_waitcnt vmcnt(0)" ::: "memory");
    const unsigned voffK = (unsigned)lane * (KLD * 2), voffR = (unsigned)lane * (ROPE * 2), voffV = (unsigned)(lane >> 2) * (KLD * 2) + (unsigned)(lane & 3) * 16;
    const char* const Kh = (const char*)(K + head * NOPE); const char* const Vh = (const char*)(V + head * VD); const char* const Rh = (const char*)KR;
#define MLA_DMA(t, slotoff) do { \
        _Pragma("unroll") for (int i_ = 0; i_ < 3; ++i_) { const int c_ = 3 * wid + i_; \
            if (c_ < 16) glds16s(Kh + (size_t)(t) * (64 * KLD * 2) + 16 * c_, voffK, lds0 + c_ * 1024 + (slotoff)); \
            else         glds16s(Rh + (size_t)(t) * (64 * ROPE * 2) + 16 * (c_ - 16), voffR, lds0 + c_ * 1024 + (slotoff)); } \
        _Pragma("unroll") for (int i_ = 0; i_ < 2; ++i_) { const int pv_ = 2 * wid + i_, db_ = pv_ >> 2, kg_ = pv_ & 3; \
            glds16s(Vh + (size_t)(t) * (64 * KLD * 2) + (size_t)(16 * kg_) * (KLD * 2) + 64 * db_, voffV, lds0 + KPART + pv_ * 1024 + (slotoff)); } } while (0)
    MLA_DMA(0, 0); MLA_DMA(1, SLOT);
    const LAS unsigned char* kb0 = lds + hi * 1024 + (32 * kh + r32) * 16;
    const LAS unsigned char* vb0 = lds + KPART + 2 * kh * 1024 + ((lane >> 4) & 1) * 32 + (lane & 3) * 8 + (4 * hi + ((lane & 15) >> 2)) * 64;
    float m = -1.0e30f, l = 0.f;
    f32x16 o[4];
#pragma unroll
    for (int d = 0; d < 4; ++d)
#pragma unroll
        for (int i = 0; i < 16; ++i) o[d][i] = 0.f;
    int slot = 0, slot2 = 2 * SLOT;
    for (int t = 0; t < NT; ++t) {
        if (t + 1 < NT) MLA_WAIT_BAR(5); else MLA_WAIT_BAR(0);
        if (t + 2 < NT) MLA_DMA(t + 2, slot2);
        f32x16 p;
#pragma unroll
        for (int i = 0; i < 16; ++i) p[i] = 0.f;
        { const LAS unsigned char* kb = kb0 + slot;
#pragma unroll
          for (int s = 0; s < 12; ++s) { const bf16x8 kf = *(const LAS bf16x8*)(kb + s * 2048); p = __builtin_amdgcn_mfma_f32_32x32x16_bf16(kf, qr[s], p, 0, 0, 0); } }
        if (t >= NT - 2) { const int kbase = 64 * (t - (NT - 2)) + 32 * kh + 4 * hi;
#pragma unroll
            for (int i = 0; i < 16; ++i) { const int key_rel = kbase + (i & 3) + 8 * (i >> 2); if (key_rel > q_rel) p[i] = -INFINITY; } }
        float mloc = fmaxf(fmaxf(p[0], p[1]), fmaxf(p[2], p[3]));
#pragma unroll
        for (int i = 4; i < 16; i += 4) mloc = fmaxf(mloc, fmaxf(fmaxf(p[i], p[i + 1]), fmaxf(p[i + 2], p[i + 3])));
        mloc = swapmax(mloc);
        if (__any(mloc > m + THR)) { const float mn = fmaxf(m, mloc), f = __builtin_amdgcn_exp2f(m - mn); m = mn; l *= f;
#pragma unroll
            for (int d = 0; d < 4; ++d)
#pragma unroll
                for (int i = 0; i < 16; ++i) o[d][i] *= f; }
        float ps = 0.f;
#pragma unroll
        for (int i = 0; i < 16; ++i) { p[i] = __builtin_amdgcn_exp2f(p[i] - m); ps += p[i]; }
        l += ps;
        u32x4 pw0, pw1;
        pw0.x = pg8::cvt_pk_bf16(p[0], p[1]); pw0.y = pg8::cvt_pk_bf16(p[2], p[3]); pw0.z = pg8::cvt_pk_bf16(p[4], p[5]); pw0.w = pg8::cvt_pk_bf16(p[6], p[7]);
        pw1.x = pg8::cvt_pk_bf16(p[8], p[9]); pw1.y = pg8::cvt_pk_bf16(p[10], p[11]); pw1.z = pg8::cvt_pk_bf16(p[12], p[13]); pw1.w = pg8::cvt_pk_bf16(p[14], p[15]);
        const bf16x8 pb0 = __builtin_bit_cast(bf16x8, pw0), pb1 = __builtin_bit_cast(bf16x8, pw1);
        { const LAS unsigned char* vb = vb0 + slot;
#pragma unroll
          for (int d = 0; d < 4; ++d) {
              const s16x4 l0 = vtr(vb + d * 4096), h0 = vtr(vb + d * 4096 + 512), l1 = vtr(vb + d * 4096 + 1024), h1 = vtr(vb + d * 4096 + 1536);
              const bf16x8 v0 = (bf16x8){l0[0], l0[1], l0[2], l0[3], h0[0], h0[1], h0[2], h0[3]}, v1 = (bf16x8){l1[0], l1[1], l1[2], l1[3], h1[0], h1[1], h1[2], h1[3]};
              o[d] = __builtin_amdgcn_mfma_f32_32x32x16_bf16(v0, pb0, o[d], 0, 0, 0);
              o[d] = __builtin_amdgcn_mfma_f32_32x32x16_bf16(v1, pb1, o[d], 0, 0, 0); } }
        slot = (slot == 2 * SLOT) ? 0 : slot + SLOT; slot2 = (slot2 == 2 * SLOT) ? 0 : slot2 + SLOT;
    }
#undef MLA_DMA
    l = swapsum(l);
    MLA_LBAR();
    LAS float* X = (LAS float*)lds + wid * 2048; LAS float* Y = (LAS float*)(lds + 65536);
#pragma unroll
    for (int d = 0; d < 2; ++d)
#pragma unroll
        for (int i = 0; i < 16; ++i) X[(d * 16 + i) * 64 + lane] = kh ? o[d][i] : o[2 + d][i];
    Y[wid * 64 + lane] = m; Y[512 + wid * 64 + lane] = l;
    MLA_LBAR();
    { const int wp = wid ^ 4; const LAS float* Xp = (const LAS float*)lds + wp * 2048;
      const float mp = Y[wp * 64 + lane], lp = Y[512 + wp * 64 + lane];
      const float mx = fmaxf(m, mp); float a = __builtin_amdgcn_exp2f(m - mx), ap = __builtin_amdgcn_exp2f(mp - mx);
      const float inv = 1.0f / (l * a + lp * ap); a *= inv; ap *= inv;
      bf16_t* op = O + (size_t)q_abs * D + head * VD + (kh ? 64 : 0) + 4 * hi;
#pragma unroll
      for (int d = 0; d < 2; ++d)
#pragma unroll
          for (int g = 0; g < 4; ++g) { float r[4];
#pragma unroll
              for (int e = 0; e < 4; ++e) { const int i = 4 * g + e; const float mine = kh ? o[2 + d][i] : o[d][i]; r[e] = mine * a + Xp[(d * 16 + i) * 64 + lane] * ap; }
              u32x2 w; w.x = pg8::cvt_pk_bf16(r[0], r[1]); w.y = pg8::cvt_pk_bf16(r[2], r[3]);
              *(u32x2*)(op + 32 * d + 8 * g) = w; } }
    MLA_LBAR();
}
#undef MLA_WAIT_BAR
#undef MLA_LBAR
}
__device__ __forceinline__ void mla_attn_phase(Frame& F) {
    const bf16_t* Q = WSP(bf16_t, WS_Q); const bf16_t* K = WSP(bf16_t, WS_K); const bf16_t* KR = WSP(bf16_t, WS_KR); const bf16_t* V = WSP(bf16_t, WS_V); bf16_t* O = WSP(bf16_t, WS_AMIX);
    for (int pr = F.vcu; pr < 256; pr += F.G) { const int head = pr >> 5, s = pr & 31;
        mla::unit(Q, K, KR, V, O, head, 63 - s, F.lds);
        mla::unit(Q, K, KR, V, O, head, s, F.lds); }
}
#ifndef STOP_AFTER
#define STOP_AFTER 99
#endif
#ifndef FAST_MLA
#define FAST_MLA 1
#endif
#ifndef FAST_GEMM
#define FAST_GEMM 1
#endif
#if FAST_GEMM
#define RUN_GEMM(EPI, g, S, E, ALIGN) pg8::gemm_phase<EPI, pg8::StaticOrder, ALIGN, true>(F.lds + RING_OFF, g, S, E)
#else
#define RUN_GEMM(EPI, g, S, E, ALIGN) pg8::gemm_ref<EPI, pg8::StaticOrder>(g, S, E)
#endif

__global__ void __launch_bounds__(NWAVES * 64, 2) fwd_kernel(Args args) {
    extern __shared__ __attribute__((aligned(16))) unsigned char lds[];
    Frame F;
    F.lds = (LAS unsigned char*)lds;
    F.MISC = (volatile LAS unsigned*)(F.lds + MISC_OFF);
    F.tid = threadIdx.x; F.lane = F.tid & 63; F.wave = __builtin_amdgcn_readfirstlane(F.tid >> 6);
    F.G = gridDim.x; { const int bx = blockIdx.x; F.vcu = (F.G % 8 == 0) ? (bx % 8) * (F.G / 8) + bx / 8 : bx; }
    unsigned char* ws = args.ws;
    F.ctl = (gu32*)(ws + WS_CTL);
    F.ws = ws; F.out = args.out;

    for (int u = F.tid; u < (LDS_BYTES - LDSCTL_OFF) / 4; u += NWAVES * 64) ((LAS unsigned*)(F.lds + LDSCTL_OFF))[u] = 0u;
    __syncthreads();
    XcdBarrier bar = xcd_barrier_post((unsigned*)(F.ctl + CW_BAR), F.MISC + 8);
#define GRID_BAR() xcd_barrier(bar)
    const int cid = (int)blockIdx.x;

    F.tid = opaque_tid(); F.lane = F.tid & 63; F.wave = __builtin_amdgcn_readfirstlane(F.tid >> 6);
    p0_prologue(F, args);
    GRID_BAR();
    if (STOP_AFTER < 1) return;
    F.tid = opaque_tid(); F.lane = F.tid & 63; F.wave = __builtin_amdgcn_readfirstlane(F.tid >> 6);
    { pg8::Gemm g{WSP(bf16_t, WS_HB), WSP(bf16_t, WS_W13A), M, 2 * FF, D, D, D}; pg8::StaticOrder S; S.init(M, 2 * FF, F.G, cid); pg8::EpiSwiGLU E{WSP(bf16_t, WS_G), FF}; RUN_GEMM(pg8::EpiSwiGLU, g, S, E, true); }
    GRID_BAR();
    if (STOP_AFTER < 2) return;
    F.tid = opaque_tid(); F.lane = F.tid & 63; F.wave = __builtin_amdgcn_readfirstlane(F.tid >> 6);
    { pg8::Gemm g{WSP(bf16_t, WS_G), WSP(bf16_t, WS_W2A), M, D, FF, FF, FF}; pg8::StaticOrder S; S.init(M, D, F.G, cid); pg8::EpiResid E{INF(0), F.out, D, ALPHA, 0.5f}; RUN_GEMM(pg8::EpiResid, g, S, E, false); }
    GRID_BAR();
    if (STOP_AFTER < 3) return;
    F.tid = opaque_tid(); F.lane = F.tid & 63; F.wave = __builtin_amdgcn_readfirstlane(F.tid >> 6);
    ln_pass(F, F.out, INF(4), INF(5), WSP(bf16_t, WS_HB));
    GRID_BAR();
    if (STOP_AFTER < 4) return;
    F.tid = opaque_tid(); F.lane = F.tid & 63; F.wave = __builtin_amdgcn_readfirstlane(F.tid >> 6);
    { pg8::Gemm g{WSP(bf16_t, WS_HB), WSP(bf16_t, WS_WIN), M, ZLD, D, D, D}; pg8::StaticOrder S; S.init(M, ZLD, F.G, cid); pg8::EpiZ E{WSP(bf16_t, WS_Z), WSP(float, WS_SSQ), WSP(bf16_t, WS_KR), WSP(float, WS_COS), WSP(float, WS_SIN)}; RUN_GEMM(pg8::EpiZ, g, S, E, true); }
    GRID_BAR();
    if (STOP_AFTER < 5) return;
    F.tid = opaque_tid(); F.lane = F.tid & 63; F.wave = __builtin_amdgcn_readfirstlane(F.tid >> 6);
    { pg8::Gemm g{WSP(bf16_t, WS_Z) + Z_CQ, WSP(bf16_t, WS_WUQ), M, QLD, QLORA, ZLD, QLORA}; pg8::StaticOrder S; S.init(M, QLD, F.G, cid); pg8::EpiQ E{WSP(bf16_t, WS_Q), WSP(float, WS_SSQ), WSP(float, WS_COS), WSP(float, WS_SIN), MLA_QSCALE}; RUN_GEMM(pg8::EpiQ, g, S, E, true); }
    { pg8::Gemm g{WSP(bf16_t, WS_Z) + Z_CKV, WSP(bf16_t, WS_WUKV), M, 2 * KLD, KVLORA, ZLD, KVLORA}; pg8::StaticOrder S; S.init(M, 2 * KLD, F.G, cid); pg8::EpiKV E{WSP(bf16_t, WS_K), WSP(bf16_t, WS_V), WSP(float, WS_SSQ)}; RUN_GEMM(pg8::EpiKV, g, S, E, true); }
    GRID_BAR();
    if (STOP_AFTER < 6) return;
    F.tid = opaque_tid(); F.lane = F.tid & 63; F.wave = __builtin_amdgcn_readfirstlane(F.tid >> 6);
#if FAST_MLA
    mla_attn_phase(F);
#else
    mla_attn_naive(F);
#endif
    swa_attn_naive(F, args);
    GRID_BAR();
    if (STOP_AFTER < 7) return;
    F.tid = opaque_tid(); F.lane = F.tid & 63; F.wave = __builtin_amdgcn_readfirstlane(F.tid >> 6);
    norm_mix_pass(F);
    GRID_BAR();
    if (STOP_AFTER < 8) return;
    F.tid = opaque_tid(); F.lane = F.tid & 63; F.wave = __builtin_amdgcn_readfirstlane(F.tid >> 6);
    { pg8::Gemm g{WSP(bf16_t, WS_AMIX), WSP(bf16_t, WS_WOUT), M, D, D, D, D}; pg8::StaticOrder S; S.init(M, D, F.G, cid); pg8::EpiResid E{F.out, F.out, D, ALPHA, 1.0f}; RUN_GEMM(pg8::EpiResid, g, S, E, false); }
    GRID_BAR();
    if (STOP_AFTER < 9) return;
    F.tid = opaque_tid(); F.lane = F.tid & 63; F.wave = __builtin_amdgcn_readfirstlane(F.tid >> 6);
    ln_pass(F, F.out, INF(18), INF(19), WSP(bf16_t, WS_HB));
    GRID_BAR();
    if (STOP_AFTER < 10) return;
    F.tid = opaque_tid(); F.lane = F.tid & 63; F.wave = __builtin_amdgcn_readfirstlane(F.tid >> 6);
    { pg8::Gemm g{WSP(bf16_t, WS_HB), WSP(bf16_t, WS_W13B), M, 2 * FF, D, D, D}; pg8::StaticOrder S; S.init(M, 2 * FF, F.G, cid); pg8::EpiSwiGLU E{WSP(bf16_t, WS_G), FF}; RUN_GEMM(pg8::EpiSwiGLU, g, S, E, true); }
    GRID_BAR();
    if (STOP_AFTER < 11) return;
    F.tid = opaque_tid(); F.lane = F.tid & 63; F.wave = __builtin_amdgcn_readfirstlane(F.tid >> 6);
    { pg8::Gemm g{WSP(bf16_t, WS_G), WSP(bf16_t, WS_W2B), M, D, FF, FF, FF}; pg8::StaticOrder S; S.init(M, D, F.G, cid); pg8::EpiResid E{F.out, F.out, D, ALPHA, 0.5f}; RUN_GEMM(pg8::EpiResid, g, S, E, false); }
    GRID_BAR();
    if (STOP_AFTER < 12) return;
    F.tid = opaque_tid(); F.lane = F.tid & 63; F.wave = __builtin_amdgcn_readfirstlane(F.tid >> 6);
    ln_pass(F, F.out, INF(23), INF(24), WSP(bf16_t, WS_HB));
    GRID_BAR();
    if (STOP_AFTER < 13) return;
    F.tid = opaque_tid(); F.lane = F.tid & 63; F.wave = __builtin_amdgcn_readfirstlane(F.tid >> 6);
    { pg8::Gemm g{WSP(bf16_t, WS_PB), WSP(bf16_t, WS_WPLE), M, D, PLE, PLE, PLE}; pg8::StaticOrder S; S.init(M, D, F.G, cid); pg8::EpiBf16 E{WSP(bf16_t, WS_PL), D}; RUN_GEMM(pg8::EpiBf16, g, S, E, false); }
    { pg8::Gemm g{WSP(bf16_t, WS_HB), WSP(bf16_t, WS_WG), M, D, D, D, D}; pg8::StaticOrder S; S.init(M, D, F.G, cid); pg8::EpiGate E{F.out, WSP(bf16_t, WS_PL), D}; RUN_GEMM(pg8::EpiGate, g, S, E, false); }
}

extern "C" void kernel_launch(void* const* d_in, const int* in_sizes, int n_in, void* d_out, int out_size, void* d_ws, size_t ws_size, hipStream_t stream) {
    static int grid = 0;
    if (grid == 0) {
        if (n_in != 27 || in_sizes[0] != M * D || out_size != M * D || ws_size < WS_END) { fprintf(stderr, "kernel_launch: unexpected shapes / workspace (n_in %d, in0 %d, out %d, ws %zu, need %zu); nothing launched\n", n_in, n_in > 0 ? in_sizes[0] : -1, out_size, ws_size, (size_t)WS_END); grid = -1; return; }
        int dev = 0, cus = 0;
        if (hipGetDevice(&dev) != hipSuccess || hipDeviceGetAttribute(&cus, hipDeviceAttributeMultiprocessorCount, dev) != hipSuccess) { grid = -1; return; }
        if (hipFuncSetAttribute((const void*)fwd_kernel, hipFuncAttributeMaxDynamicSharedMemorySize, LDS_BYTES) != hipSuccess) { fprintf(stderr, "kernel_launch: hipFuncSetAttribute failed\n"); grid = -1; return; }
        int per_cu = 0;
        if (hipOccupancyMaxActiveBlocksPerMultiprocessor(&per_cu, (const void*)fwd_kernel, NWAVES * 64, LDS_BYTES) != hipSuccess || per_cu < 1) fprintf(stderr, "kernel_launch: occupancy query reports %d\n", per_cu);
        (void)hipGetLastError();
        grid = cus;
    }
    if (grid < 0) return;
    if (hipMemsetAsync((char*)d_ws + WS_CTL, 0, CTL_ZERO_BYTES, stream) != hipSuccess) return;
    Args a{};
    for (int i = 0; i < 27; ++i) a.in[i] = d_in[i];
    a.out = (float*)d_out; a.ws = (unsigned char*)d_ws;
    hipLaunchKernelGGL(fwd_kernel, dim3(grid), dim3(NWAVES * 64), LDS_BYTES, stream, a);
}
```

```cpp
#include <hip/hip_runtime.h>
#include <cstdio>
#include <cstdint>

#define LAS __attribute__((address_space(3)))
#define GAS __attribute__((address_space(1)))
typedef unsigned short bf16_t;
typedef short bf16x8 __attribute__((ext_vector_type(8)));
typedef float f32x4 __attribute__((ext_vector_type(4)));
typedef float f32x2 __attribute__((ext_vector_type(2)));
typedef unsigned u32x4 __attribute__((ext_vector_type(4)));
typedef unsigned u32x2 __attribute__((ext_vector_type(2)));
typedef GAS unsigned gu32;

constexpr int M = 8192, D = 2048, FF = 5632, PLE = 256, DIN = 2368;
constexpr int ZLD = 2560;
constexpr int NH = 8, NOPE = 128, ROPE = 64, QKD = 192, VD = 128, QLORA = 512, KVLORA = 512;
constexpr int QLD = NH * QKD;
constexpr int KLD = NH * NOPE;
constexpr int SWH = 16, SWKV = 2, SWD = 64, WINDOW = 128;
constexpr float ALPHA = 1.189207115002721f, LN_EPS = 1e-5f;
constexpr float LOG2E = 1.4426950408889634f;
constexpr float MLA_QSCALE = 0.10411754627697264f;
constexpr float SWA_SCALE2 = 0.18033688011112042f;
constexpr int Z_CQ = 0, Z_CKV = 512, Z_QS = 1024, Z_KS = 2048, Z_VS = 2176;

constexpr size_t MiB = 1u << 20;
constexpr size_t WS_CTL = 0, CTL_ZERO_BYTES = 1 * MiB;
constexpr size_t WS_COS = 1 * MiB, WS_SIN = 2 * MiB;
constexpr size_t WS_BIAS = 3 * MiB;
constexpr size_t WS_SSQ = 3 * MiB + 65536;
constexpr size_t WS_W13A = 4 * MiB;
constexpr size_t WS_W2A = WS_W13A + 44 * MiB;
constexpr size_t WS_W13B = WS_W2A + 22 * MiB;
constexpr size_t WS_W2B = WS_W13B + 44 * MiB;
constexpr size_t WS_WIN = WS_W2B + 22 * MiB;
constexpr size_t WS_WUQ = WS_WIN + 10 * MiB;
constexpr size_t WS_WUKV = WS_WUQ + 2 * MiB;
constexpr size_t WS_WOUT = WS_WUKV + 2 * MiB;
constexpr size_t WS_WG = WS_WOUT + 8 * MiB;
constexpr size_t WS_WPLE = WS_WG + 8 * MiB;
constexpr size_t WS_HB = WS_WPLE + 1 * MiB;
constexpr size_t WS_PB = WS_HB + 32 * MiB;
constexpr size_t WS_PL = WS_PB + 4 * MiB;
constexpr size_t WS_R = WS_PL + 32 * MiB;
constexpr size_t WS_G = WS_R;
constexpr size_t WS_Z = WS_R;
constexpr size_t WS_Q = WS_Z + 40 * MiB;
constexpr size_t WS_K = WS_Q + 24 * MiB;
constexpr size_t WS_V = WS_K + 16 * MiB;
constexpr size_t WS_KR = WS_V + 16 * MiB;
constexpr size_t WS_AMIX = WS_KR + 1 * MiB;
constexpr size_t WS_END = WS_AMIX + 32 * MiB;
static_assert(WS_G + (size_t)M * FF * 2 <= WS_END, "G overlay fits");
constexpr int CW_BAR = 4096;

__device__ __forceinline__ float bf2f(bf16_t b) { return __uint_as_float((unsigned)b << 16); }
__device__ __forceinline__ unsigned f2bf(float f) { unsigned u = __float_as_uint(f); return (u + 0x7fffu + ((u >> 16) & 1u)) >> 16; }
__device__ __forceinline__ unsigned pk2(float lo, float hi) { return f2bf(lo) | (f2bf(hi) << 16); }
__device__ __forceinline__ float wave_sum(float v) {
#pragma unroll
    for (int o = 1; o < 64; o <<= 1) v += __shfl_xor(v, o);
    return v;
}
__device__ __forceinline__ float wave_max(float v) {
#pragma unroll
    for (int o = 1; o < 64; o <<= 1) v = fmaxf(v, __shfl_xor(v, o));
    return v;
}
__device__ __forceinline__ int opaque_tid() { int t = threadIdx.x; asm volatile("" : "+v"(t)); return t; }
namespace pg8 {
#define PG8_LAS __attribute__((address_space(3)))
constexpr int BM = 256, BK = 64, HALF = 128, HTB = HALF * BK * 2  , STAGE_BYTES = 8 * HTB, NXCD = 8, WGM = 8;

__host__ __device__ __forceinline__ int lds_byte(int r, int c) { const int st = (r >> 4) * 2 + (c >> 5), rr = r & 15, cc = c & 31, ob = rr * 64 + cc * 2; return st * 1024 + (ob ^ (((ob >> 9) & 1) << 5)); }
__host__ __device__ __forceinline__ void stage_rc(int b, int& R, int& C) { const int st = b / 1024, sb = b % 1024, swz = sb ^ (((sb >> 9) & 1) << 5); R = (st >> 1) * 16 + swz / 64; C = (st & 1) * 32 + (swz % 64) / 2; }
__host__ __device__ __forceinline__ int perm32(int rho) { const int n = rho >> 4, i = rho & 15; return 8 * (i >> 2) + 4 * n + (i & 3); }

struct Unit { int pm, pn; };
struct Gemm { const bf16_t* A; const bf16_t* Bt; int M, N, K, lda, ldb; };

struct StaticOrder {
    int nM, nN, nwg, G, c;
    __host__ __device__ void init(int M_, int N_, int G_, int c_) { nM = M_ / BM; nN = N_ / BM; nwg = nM * nN; G = G_; c = c_; }
    __host__ __device__ bool next(int i, Unit& u) const {
        const long L = (long)i * G + c; if (L >= nwg) return false;
        int wgid = (int)L; { const int q = nwg / NXCD, r = nwg % NXCD, xcd = wgid % NXCD, off = wgid / NXCD; wgid = (xcd < r ? xcd * (q + 1) : r * (q + 1) + (xcd - r) * q) + off; }
        const int nig = WGM * nN, gid = wgid / nig, fm = gid * WGM, gsz = (nM - fm) < WGM ? (nM - fm) : WGM;
        u.pm = fm + ((wgid % nig) % gsz); u.pn = (wgid % nig) / gsz; return true;
    }
    __device__ __forceinline__ void a_ready(const Unit&) const {}
    __device__ __forceinline__ void done(const Unit&) const {}
};

typedef __bf16 bf16x2_t __attribute__((ext_vector_type(2)));
__device__ __forceinline__ unsigned cvt_pk_bf16(float lo, float hi) { const f32x2 v = {lo, hi}; const bf16x2_t b = __builtin_convertvector(v, bf16x2_t); return __builtin_bit_cast(unsigned, b); }
__device__ __forceinline__ u32x4 pack8(const f32x4 v0, const f32x4 v1) { u32x4 w; w.x = cvt_pk_bf16(v0[0], v0[1]); w.y = cvt_pk_bf16(v0[2], v0[3]); w.z = cvt_pk_bf16(v1[0], v1[1]); w.w = cvt_pk_bf16(v1[2], v1[3]); return w; }
__device__ __forceinline__ float sigmoidf_fast(float v) { return __builtin_amdgcn_rcpf(1.0f + __builtin_amdgcn_exp2f(-v * 1.4426950408889634f)); }

struct EpiBf16 {
    static constexpr bool PERM = true, AFTER_DRAIN = false;
    bf16_t* O; int ldc;
    __device__ __forceinline__ void operator()(const f32x4 (&acc)[2][2][4][2], const Unit& u, int wr, int wc, int fr, int fq) const {
        const int row0 = u.pm * BM + wr * 64 + fr, col0 = u.pn * BM + wc * 32 + 8 * fq;
#pragma unroll
        for (int ai = 0; ai < 2; ++ai)
#pragma unroll
            for (int m = 0; m < 4; ++m) { bf16_t* rowp = O + (size_t)(row0 + ai * HALF + m * 16) * ldc + col0;
#pragma unroll
                for (int bj = 0; bj < 2; ++bj) *(u32x4*)(rowp + bj * HALF) = pack8(acc[ai][bj][m][0], acc[ai][bj][m][1]); }
    }
};
struct EpiSwiGLU {
    static constexpr bool PERM = true, AFTER_DRAIN = false;
    bf16_t* G; int ldc;
    __device__ __forceinline__ void operator()(const f32x4 (&acc)[2][2][4][2], const Unit& u, int wr, int wc, int fr, int fq) const {
        const int row0 = u.pm * BM + wr * 64 + fr, col0 = u.pn * HALF + wc * 32 + 8 * fq;
#pragma unroll
        for (int ai = 0; ai < 2; ++ai)
#pragma unroll
            for (int m = 0; m < 4; ++m) { bf16_t* rowp = G + (size_t)(row0 + ai * HALF + m * 16) * ldc + col0;
                f32x4 g[2];
#pragma unroll
                for (int n = 0; n < 2; ++n)
#pragma unroll
                    for (int e = 0; e < 4; ++e) { const float a = acc[ai][0][m][n][e], b = acc[ai][1][m][n][e]; g[n][e] = a * sigmoidf_fast(a) * b; }
                *(u32x4*)rowp = pack8(g[0], g[1]); }
    }
};
struct EpiResid {
    static constexpr bool PERM = false, AFTER_DRAIN = false;
    const float* res; float* out; int ldc; float alpha, s;
    __device__ __forceinline__ void operator()(const f32x4 (&acc)[2][2][4][2], const Unit& u, int wr, int wc, int fr, int fq) const {
        const int row0 = u.pm * BM + wr * 64 + fr, col0 = u.pn * BM + wc * 32 + 4 * fq;
#pragma unroll
        for (int ai = 0; ai < 2; ++ai)
#pragma unroll
            for (int m = 0; m < 4; ++m) { const size_t off = (size_t)(row0 + ai * HALF + m * 16) * ldc + col0;
#pragma unroll
                for (int bj = 0; bj < 2; ++bj)
#pragma unroll
                    for (int n = 0; n < 2; ++n) { const f32x4 r = *(const f32x4*)(res + off + bj * HALF + n * 16); *(f32x4*)(out + off + bj * HALF + n * 16) = r * alpha + acc[ai][bj][m][n] * s; } }
    }
};
struct EpiGate {
    static constexpr bool PERM = false, AFTER_DRAIN = false;
    float* out; const bf16_t* pl; int ldc;
    __device__ __forceinline__ void operator()(const f32x4 (&acc)[2][2][4][2], const Unit& u, int wr, int wc, int fr, int fq) const {
        const int row0 = u.pm * BM + wr * 64 + fr, col0 = u.pn * BM + wc * 32 + 4 * fq;
#pragma unroll
        for (int ai = 0; ai < 2; ++ai)
#pragma unroll
            for (int m = 0; m < 4; ++m) { const size_t off = (size_t)(row0 + ai * HALF + m * 16) * ldc + col0;
#pragma unroll
                for (int bj = 0; bj < 2; ++bj)
#pragma unroll
                    for (int n = 0; n < 2; ++n) { const size_t o = off + bj * HALF + n * 16; const f32x4 h = *(const f32x4*)(out + o); const u32x2 pw = *(const u32x2*)(pl + o);
                        f32x4 p; p[0] = __uint_as_float(pw.x << 16); p[1] = __uint_as_float(pw.x & 0xffff0000u); p[2] = __uint_as_float(pw.y << 16); p[3] = __uint_as_float(pw.y & 0xffff0000u);
                        f32x4 r;
#pragma unroll
                        for (int e = 0; e < 4; ++e) r[e] = h[e] + sigmoidf_fast(acc[ai][bj][m][n][e]) * p[e];
                        *(f32x4*)(out + o) = r; } }
    }
};
struct EpiZ {
    static constexpr bool PERM = true, AFTER_DRAIN = false;
    bf16_t* Z; float* ssq; bf16_t* KR; const float* cs; const float* sn;
    __device__ __forceinline__ void operator()(const f32x4 (&acc)[2][2][4][2], const Unit& u, int wr, int wc, int fr, int fq) const {
        const int row0 = u.pm * BM + wr * 64 + fr;
        if (u.pn < 9) {
            const int col0 = u.pn * BM + wc * 32 + 8 * fq;
#pragma unroll
            for (int ai = 0; ai < 2; ++ai)
#pragma unroll
                for (int m = 0; m < 4; ++m) { const int row = row0 + ai * HALF + m * 16; bf16_t* rowp = Z + (size_t)row * ZLD + col0;
#pragma unroll
                    for (int bj = 0; bj < 2; ++bj) *(u32x4*)(rowp + bj * HALF) = pack8(acc[ai][bj][m][0], acc[ai][bj][m][1]);
                    if (u.pn < 4) { float s = 0.f;
#pragma unroll
                        for (int bj = 0; bj < 2; ++bj)
#pragma unroll
                            for (int n = 0; n < 2; ++n) { const f32x4 x = acc[ai][bj][m][n]; s += (x[0] * x[0] + x[1] * x[1]) + (x[2] * x[2] + x[3] * x[3]); }
                        s += __shfl_xor(s, 16); s += __shfl_xor(s, 32);
                        if (fq == 0) ssq[(size_t)row * 16 + u.pn * 4 + wc] = s; } }
        } else if (wc == 0) {
#pragma unroll
            for (int ai = 0; ai < 2; ++ai)
#pragma unroll
                for (int m = 0; m < 4; ++m) { const int row = row0 + ai * HALF + m * 16; f32x4 o1[2], o2[2];
#pragma unroll
                    for (int n = 0; n < 2; ++n) { const f32x4 c = *(const f32x4*)(cs + (size_t)row * 32 + 8 * fq + 4 * n), s = *(const f32x4*)(sn + (size_t)row * 32 + 8 * fq + 4 * n);
                        const f32x4 x1 = acc[ai][0][m][n], x2 = acc[ai][1][m][n]; o1[n] = x1 * c - x2 * s; o2[n] = x1 * s + x2 * c; }
                    *(u32x4*)(KR + (size_t)row * 64 + 8 * fq) = pack8(o1[0], o1[1]); *(u32x4*)(KR + (size_t)row * 64 + 32 + 8 * fq) = pack8(o2[0], o2[1]); }
        }
    }
};
struct EpiQ {
    static constexpr bool PERM = true, AFTER_DRAIN = false;
    bf16_t* Q; const float* ssq; const float* cs; const float* sn; float qscale;
    __device__ __forceinline__ void operator()(const f32x4 (&acc)[2][2][4][2], const Unit& u, int wr, int wc, int fr, int fq) const {
        const int row0 = u.pm * BM + wr * 64 + fr;
#pragma unroll
        for (int ai = 0; ai < 2; ++ai)
#pragma unroll
            for (int m = 0; m < 4; ++m) { const int row = row0 + ai * HALF + m * 16;
                const f32x4 p0 = *(const f32x4*)(ssq + (size_t)row * 16), p1 = *(const f32x4*)(ssq + (size_t)row * 16 + 4);
                const float rs = qscale / sqrtf(((p0[0] + p0[1]) + (p0[2] + p0[3]) + (p1[0] + p1[1]) + (p1[2] + p1[3])) * (1.0f / QLORA) + LN_EPS);
                if (u.pn < 4) {
#pragma unroll
                    for (int bj = 0; bj < 2; ++bj) *(u32x4*)(Q + (size_t)row * QLD + (2 * u.pn + bj) * QKD + wc * 32 + 8 * fq) = pack8(acc[ai][bj][m][0] * rs, acc[ai][bj][m][1] * rs);
                } else { const int head = 4 * (u.pn - 4) + wc; f32x4 o1[2], o2[2];
#pragma unroll
                    for (int n = 0; n < 2; ++n) { const f32x4 c = *(const f32x4*)(cs + (size_t)row * 32 + 8 * fq + 4 * n), s = *(const f32x4*)(sn + (size_t)row * 32 + 8 * fq + 4 * n);
                        const f32x4 x1 = acc[ai][0][m][n] * rs, x2 = acc[ai][1][m][n] * rs; o1[n] = x1 * c - x2 * s; o2[n] = x1 * s + x2 * c; }
                    bf16_t* qp = Q + (size_t)row * QLD + head * QKD + NOPE + 8 * fq;
                    *(u32x4*)qp = pack8(o1[0], o1[1]); *(u32x4*)(qp + 32) = pack8(o2[0], o2[1]); } }
    }
};
struct EpiKV {
    static constexpr bool PERM = true, AFTER_DRAIN = false;
    bf16_t* Kb; bf16_t* Vb; const float* ssq;
    __device__ __forceinline__ void operator()(const f32x4 (&acc)[2][2][4][2], const Unit& u, int wr, int wc, int fr, int fq) const {
        const int row0 = u.pm * BM + wr * 64 + fr;
#pragma unroll
        for (int ai = 0; ai < 2; ++ai)
#pragma unroll
            for (int m = 0; m < 4; ++m) { const int row = row0 + ai * HALF + m * 16;
                const f32x4 p0 = *(const f32x4*)(ssq + (size_t)row * 16 + 8), p1 = *(const f32x4*)(ssq + (size_t)row * 16 + 12);
                const float rs = 1.0f / sqrtf(((p0[0] + p0[1]) + (p0[2] + p0[3]) + (p1[0] + p1[1]) + (p1[2] + p1[3])) * (1.0f / KVLORA) + LN_EPS);
                const size_t o = (size_t)row * KLD + u.pn * NOPE + wc * 32 + 8 * fq;
                *(u32x4*)(Kb + o) = pack8(acc[ai][0][m][0] * rs, acc[ai][0][m][1] * rs);
                *(u32x4*)(Vb + o) = pack8(acc[ai][1][m][0] * rs, acc[ai][1][m][1] * rs); }
    }
};

template <class Epi, class Sched>
__device__ __forceinline__ void gemm_ref(const Gemm g, const Sched& S, const Epi& E) {
    const int tid = opaque_tid(), wid = __builtin_amdgcn_readfirstlane(tid >> 6), lane = tid & 63, wr = wid >> 2, wc = wid & 3, fr = lane & 15, fq = lane >> 4;
    Unit u;
    for (int i = 0; S.next(i, u); ++i) {
        f32x4 acc[2][2][4][2];
#pragma unroll
        for (int a = 0; a < 2; ++a)
#pragma unroll
            for (int b = 0; b < 2; ++b)
#pragma unroll
                for (int m = 0; m < 4; ++m)
#pragma unroll
                    for (int n = 0; n < 2; ++n) acc[a][b][m][n] = (f32x4){0.f, 0.f, 0.f, 0.f};
        const bf16_t* Ab = g.A + (size_t)(u.pm * BM + wr * 64 + fr) * g.lda + fq * 8;
        const bf16_t* Bb = g.Bt + (size_t)(u.pn * BM + wc * 32) * g.ldb + fq * 8;
        const int rb0 = Epi::PERM ? perm32(fr) : fr, rb1 = Epi::PERM ? perm32(16 + fr) : 16 + fr;
        for (int k = 0; k < g.K; k += 32) {
            bf16x8 a[2][4], b[2][2];
#pragma unroll
            for (int ai = 0; ai < 2; ++ai)
#pragma unroll
                for (int m = 0; m < 4; ++m) a[ai][m] = *(const bf16x8*)(Ab + (size_t)(ai * HALF + m * 16) * g.lda + k);
#pragma unroll
            for (int bj = 0; bj < 2; ++bj) { b[bj][0] = *(const bf16x8*)(Bb + (size_t)(bj * HALF + rb0) * g.ldb + k); b[bj][1] = *(const bf16x8*)(Bb + (size_t)(bj * HALF + rb1) * g.ldb + k); }
#pragma unroll
            for (int ai = 0; ai < 2; ++ai)
#pragma unroll
                for (int bj = 0; bj < 2; ++bj)
#pragma unroll
                    for (int m = 0; m < 4; ++m)
#pragma unroll
                        for (int n = 0; n < 2; ++n) acc[ai][bj][m][n] = __builtin_amdgcn_mfma_f32_16x16x32_bf16(b[bj][n], a[ai][m], acc[ai][bj][m][n], 0, 0, 0);
        }
        E(acc, u, wr, wc, fr, fq);
    }
}
template <class Epi, class Sched, bool ALIGN_EPI = false, bool SP2 = false>
__device__ __forceinline__ void gemm_phase(PG8_LAS unsigned char* lds, const Gemm g, const Sched& S, const Epi& E) {
    const int tid = opaque_tid(), wid = __builtin_amdgcn_readfirstlane(tid >> 6), lane = tid & 63, wr = wid >> 2, wc = wid & 3, fr = lane & 15, fq = lane >> 4;
    const int K = g.K, nt = K / BK;
    unsigned voffA[2], voffB[2];
#pragma unroll
    for (int i = 0; i < 2; ++i) { int R, C; stage_rc(tid * 16 + i * 8192, R, C); const int Rb = Epi::PERM ? ((R & ~31) + perm32(R & 31)) : R;
        voffA[i] = (unsigned)(R * g.lda + C) * 2u; voffB[i] = (unsigned)(Rb * g.ldb + C) * 2u; }
    const size_t kstep = (size_t)(BK * 2);
    const size_t hstepA = (size_t)HALF * g.lda * 2, hstepB = (size_t)HALF * g.ldb * 2;
    const size_t tstepA = 2 * hstepA, tstepB = 2 * hstepB;
    const unsigned ldsw = (unsigned)wid * 1024u;
    const int aoff = lds_byte(wr * 64 + fr, fq * 8), boff = lds_byte(wc * 32 + fr, fq * 8);
#define PG8_SA(b, h) (((b) * 2 + (h)) * HTB)
#define PG8_SB(b, h) ((4 + (b) * 2 + (h)) * HTB)
#define PG8_STAGE(bufoff, gbase, voff) do { _Pragma("unroll") for (int _i = 0; _i < 2; ++_i) \
        __builtin_amdgcn_global_load_lds((const unsigned*)((const char*)(gbase) + (voff)[_i]), (PG8_LAS unsigned*)(lds + (bufoff) + ldsw + _i * 8192), 16, 0, 0); } while (0)
#define PG8_LDA(dst, b, h) do { _Pragma("unroll") for (int m = 0; m < 4; ++m) _Pragma("unroll") for (int k = 0; k < 2; ++k) dst[m][k] = *(const PG8_LAS bf16x8*)(lds + PG8_SA(b, h) + aoff + m * 2048 + k * 1024); } while (0)
#define PG8_LDB(dst, b, h) do { _Pragma("unroll") for (int n = 0; n < 2; ++n) _Pragma("unroll") for (int k = 0; k < 2; ++k) dst[n][k] = *(const PG8_LAS bf16x8*)(lds + PG8_SB(b, h) + boff + n * 2048 + k * 1024); } while (0)
#define PG8_MMA(ai, bj, At, Bt) do { __builtin_amdgcn_s_setprio(1); _Pragma("unroll") for (int m = 0; m < 4; ++m) _Pragma("unroll") for (int n = 0; n < 2; ++n) _Pragma("unroll") for (int k = 0; k < 2; ++k) \
        acc[ai][bj][m][n] = __builtin_amdgcn_mfma_f32_16x16x32_bf16(Bt[n][k], At[m][k], acc[ai][bj][m][n], 0, 0, 0); __builtin_amdgcn_s_setprio(0); } while (0)
#define PG8_WAIT_V(n) asm volatile("s_waitcnt vmcnt(" #n ")" ::: "memory")
#define PG8_WAIT_L(n) asm volatile("s_waitcnt lgkmcnt(" #n ")" ::: "memory")
#define PG8_BAR __builtin_amdgcn_s_barrier()
#define PG8_SCHED __builtin_amdgcn_sched_barrier(0)
    Unit cur, nxt; int ui = 0;
    if (!S.next(0, cur)) return;
    f32x4 acc[2][2][4][2];
#pragma unroll
    for (int a = 0; a < 2; ++a)
#pragma unroll
        for (int b = 0; b < 2; ++b)
#pragma unroll
            for (int m = 0; m < 4; ++m)
#pragma unroll
                for (int n = 0; n < 2; ++n) acc[a][b][m][n] = (f32x4){0.f, 0.f, 0.f, 0.f};
    bf16x8 At[4][2], B0[2][2], B1[2][2];
    const char* cA = (const char*)g.A + (size_t)cur.pm * tstepA; const char* cB = (const char*)g.Bt + (size_t)cur.pn * tstepB;
    S.a_ready(cur);
    if constexpr (SP2) {
        PG8_STAGE(PG8_SB(0, 0), cB, voffB); PG8_STAGE(PG8_SB(0, 1), cB + hstepB, voffB); PG8_STAGE(PG8_SA(0, 0), cA, voffA); PG8_STAGE(PG8_SA(0, 1), cA + hstepA, voffA);
        if (wr == 1) PG8_BAR;
        PG8_WAIT_V(2); PG8_BAR;
        PG8_STAGE(PG8_SB(1, 0), cB + kstep, voffB); PG8_STAGE(PG8_SA(1, 0), cA + kstep, voffA); PG8_STAGE(PG8_SB(1, 1), cB + hstepB + kstep, voffB);
        PG8_WAIT_V(6); PG8_BAR;
    } else {
        PG8_STAGE(PG8_SB(0, 0), cB, voffB); PG8_STAGE(PG8_SA(0, 0), cA, voffA); PG8_STAGE(PG8_SB(0, 1), cB + hstepB, voffB); PG8_STAGE(PG8_SA(0, 1), cA + hstepA, voffA);
        if (wr == 1) PG8_BAR;
        PG8_WAIT_V(4); PG8_BAR;
        PG8_STAGE(PG8_SB(1, 0), cB + kstep, voffB); PG8_STAGE(PG8_SA(1, 0), cA + kstep, voffA); PG8_STAGE(PG8_SB(1, 1), cB + hstepB + kstep, voffB);
        PG8_WAIT_V(6); PG8_BAR;
    }
    for (;;) {
        const bool has_next = S.next(ui + 1, nxt);
        const char* nA = has_next ? (const char*)g.A + (size_t)nxt.pm * tstepA : cA; const char* nB = has_next ? (const char*)g.Bt + (size_t)nxt.pn * tstepB : cB;
        for (int t = 0; t < nt; t += 2) {
            const bool last = (t == nt - 2);
            const char* a1 = cA + (size_t)(t + 1) * kstep;
            const char* a2 = last ? nA : cA + (size_t)(t + 2) * kstep; const char* b2 = last ? nB : cB + (size_t)(t + 2) * kstep;
            const char* a3 = a2 + kstep; const char* b3 = b2 + kstep;
            if (last && has_next) S.a_ready(nxt);
            if constexpr (SP2) {
            PG8_LDB(B0, 0, 0); PG8_LDB(B1, 0, 1); PG8_SCHED; PG8_LDA(At, 0, 0); PG8_STAGE(PG8_SA(1, 1), a1 + hstepA, voffA);
            PG8_WAIT_V(8); PG8_WAIT_L(0); PG8_BAR; PG8_MMA(0, 0, At, B0); PG8_MMA(0, 1, At, B1); PG8_BAR; PG8_SCHED;
            PG8_LDA(At, 0, 1); PG8_STAGE(PG8_SB(0, 0), b2, voffB); PG8_STAGE(PG8_SB(0, 1), b2 + hstepB, voffB); PG8_STAGE(PG8_SA(0, 0), a2, voffA);
            PG8_WAIT_V(8); PG8_WAIT_L(0); PG8_BAR; PG8_MMA(1, 0, At, B0); PG8_MMA(1, 1, At, B1); PG8_BAR; PG8_SCHED;
            PG8_LDB(B0, 1, 0); PG8_LDB(B1, 1, 1); PG8_SCHED; PG8_LDA(At, 1, 0); PG8_STAGE(PG8_SA(0, 1), a2 + hstepA, voffA);
            PG8_WAIT_V(8); PG8_WAIT_L(0); PG8_BAR; PG8_MMA(0, 0, At, B0); PG8_MMA(0, 1, At, B1); PG8_BAR; PG8_SCHED;
            PG8_LDA(At, 1, 1); PG8_STAGE(PG8_SB(1, 0), b3, voffB); PG8_STAGE(PG8_SB(1, 1), b3 + hstepB, voffB); PG8_STAGE(PG8_SA(1, 0), a3, voffA);
            PG8_WAIT_V(8); PG8_WAIT_L(0); PG8_BAR; PG8_MMA(1, 0, At, B0); PG8_MMA(1, 1, At, B1); PG8_BAR; PG8_SCHED;
            } else {
            PG8_LDB(B0, 0, 0); PG8_SCHED; PG8_LDA(At, 0, 0); PG8_STAGE(PG8_SA(1, 1), a1 + hstepA, voffA);
            PG8_WAIT_L(8); PG8_BAR; PG8_WAIT_L(0); PG8_MMA(0, 0, At, B0); PG8_BAR; PG8_SCHED;
            PG8_LDB(B1, 0, 1); PG8_STAGE(PG8_SB(0, 0), b2, voffB);
            PG8_BAR; PG8_WAIT_L(0); PG8_MMA(0, 1, At, B1); PG8_BAR;
            PG8_LDA(At, 0, 1); PG8_STAGE(PG8_SA(0, 0), a2, voffA);
            PG8_BAR; PG8_WAIT_L(0); PG8_MMA(1, 0, At, B0); PG8_BAR; PG8_SCHED;
            PG8_STAGE(PG8_SB(0, 1), b2 + hstepB, voffB);
            PG8_WAIT_V(6); PG8_BAR; PG8_MMA(1, 1, At, B1); PG8_BAR;
            PG8_LDB(B0, 1, 0); PG8_SCHED; PG8_LDA(At, 1, 0); PG8_STAGE(PG8_SA(0, 1), a2 + hstepA, voffA);
            PG8_WAIT_L(8); PG8_BAR; PG8_WAIT_L(0); PG8_MMA(0, 0, At, B0); PG8_BAR; PG8_SCHED;
            PG8_LDB(B1, 1, 1); PG8_STAGE(PG8_SB(1, 0), b3, voffB);
            PG8_BAR; PG8_WAIT_L(0); PG8_MMA(0, 1, At, B1); PG8_BAR;
            PG8_LDA(At, 1, 1); PG8_STAGE(PG8_SA(1, 0), a3, voffA);
            PG8_BAR; PG8_WAIT_L(0); PG8_MMA(1, 0, At, B0); PG8_BAR; PG8_SCHED;
            PG8_STAGE(PG8_SB(1, 1), b3 + hstepB, voffB);
            PG8_WAIT_V(6); PG8_BAR; PG8_MMA(1, 1, At, B1); PG8_BAR;
            }
        }
        if constexpr (ALIGN_EPI) { if (wr == 0) PG8_BAR; }
        if constexpr (!Epi::AFTER_DRAIN) { E(acc, cur, wr, wc, fr, fq); S.done(cur); }
        if (!has_next) break;
#pragma unroll
        for (int a = 0; a < 2; ++a)
#pragma unroll
            for (int b = 0; b < 2; ++b)
#pragma unroll
                for (int m = 0; m < 4; ++m)
#pragma unroll
                    for (int n = 0; n < 2; ++n) acc[a][b][m][n] = (f32x4){0.f, 0.f, 0.f, 0.f};
        cur = nxt; cA = nA; cB = nB; ++ui;
        if constexpr (ALIGN_EPI) { if (wr == 1) PG8_BAR; }
    }
    PG8_WAIT_V(0);
    if constexpr (!ALIGN_EPI) { if (wr == 0) PG8_BAR; }
    PG8_BAR;
    if constexpr (Epi::AFTER_DRAIN) { E.fused(acc, cur, wr, wc, fr, fq, lds, wid, lane); S.done(cur); }
#undef PG8_SA
#undef PG8_SB
#undef PG8_STAGE
#undef PG8_LDA
#undef PG8_LDB
#undef PG8_MMA
#undef PG8_WAIT_V
#undef PG8_WAIT_L
#undef PG8_BAR
#undef PG8_SCHED
}
}

#define RLX_AGENT __ATOMIC_RELAXED, __HIP_MEMORY_SCOPE_AGENT
#define LDS_WAIT() asm volatile("s_waitcnt lgkmcnt(0)" ::: "memory")
#define VM_WAIT() asm volatile("s_waitcnt vmcnt(0)" ::: "memory")
#define XB_TMO      128
#define XB_XCNT(j)  (256  + 64 * (j))
#define XB_XSUB(j)  (1280 + 64 * (j))
#define XB_XGEN(j)  (2304 + 64 * (j))
#define XB_TOP      3328
#define XB_TOPGEN   3392
#define XCD_BAR_WORDS 3456
#define XB_SPIN_CAP (1u << 25)

__device__ __forceinline__ unsigned xb_ld(unsigned* p)              { return __hip_atomic_load(p, __ATOMIC_RELAXED, __HIP_MEMORY_SCOPE_AGENT); }
__device__ __forceinline__ unsigned xb_add(unsigned* p, unsigned v) { return __hip_atomic_fetch_add(p, v, __ATOMIC_RELAXED, __HIP_MEMORY_SCOPE_AGENT); }
__device__ __forceinline__ unsigned xb_xcc_id() { return (unsigned)__builtin_amdgcn_s_getreg((3 << 11) | 20) & 0xFu; }
#define XB_SPIN(cond, bar) do { unsigned _sp = 0; while (cond) { __builtin_amdgcn_s_sleep(1); \
    if ((++_sp & 255u) == 0u) { if (xb_ld(&(bar)[XB_TMO])) break; if (_sp > XB_SPIN_CAP) { atomicAdd(&(bar)[XB_TMO], 1u); break; } } } } while (0)

struct XcdBarrier {
    unsigned* bar; unsigned x;
    volatile LAS unsigned* st;
};

__device__ __forceinline__ XcdBarrier xcd_barrier_post(unsigned* bar, volatile LAS unsigned* st) {
    XcdBarrier b; b.bar = bar; b.x = xb_xcc_id(); b.st = st;
    if (threadIdx.x == 0) (void)xb_add(&bar[XB_XCNT(b.x)], 1u);
    return b;
}
__device__ __forceinline__ void xcd_barrier_complete(unsigned* bar, unsigned x, unsigned& nloc, unsigned& nx) {
    const unsigned G = gridDim.x * gridDim.y * gridDim.z;
    unsigned sum, cnt, mine, sp = 0u;
    for (;;) {
        sum = 0u; cnt = 0u; mine = 0u;
#pragma unroll
        for (unsigned j = 0; j < 16; ++j) { const unsigned c = xb_ld(&bar[XB_XCNT(j)]); sum += c; cnt += (c > 0u) ? 1u : 0u; mine = (j == x) ? c : mine; }
        if (sum == G) break;
        __builtin_amdgcn_s_sleep(1);
        if ((++sp & 255u) == 0u) { if (xb_ld(&bar[XB_TMO])) break; if (sp > XB_SPIN_CAP) { atomicAdd(&bar[XB_TMO], 1u); break; } }
    }
    nloc = mine > 0u ? mine : 1u; nx = cnt > 0u ? cnt : 1u;
}

__device__ __forceinline__ void xcd_barrier(const XcdBarrier& b) {
    asm volatile("s_waitcnt vmcnt(0)" ::: "memory");
    __syncthreads();
    if (threadIdx.x == 0) {
        unsigned* bar = b.bar;
        __builtin_amdgcn_s_waitcnt(0);
        unsigned nloc = b.st[0], nx = b.st[1];
        if (nloc == 0u) { xcd_barrier_complete(bar, b.x, nloc, nx); b.st[0] = nloc; b.st[1] = nx; }
        const unsigned old = xb_add(&bar[XB_XSUB(b.x)], 1u);
        const unsigned gen = old / nloc;
        if (old + 1u == (gen + 1u) * nloc) {
            __builtin_amdgcn_fence(__ATOMIC_RELEASE, "agent");
            asm volatile("s_waitcnt vmcnt(0)" ::: "memory");
            const unsigned og = xb_add(&bar[XB_TOP], 1u);
            const unsigned tg = og / nx;
            if (og + 1u == (tg + 1u) * nx) xb_add(&bar[XB_TOPGEN], 1u);
            else XB_SPIN(xb_ld(&bar[XB_TOPGEN]) == tg, bar);
            __builtin_amdgcn_fence(__ATOMIC_ACQUIRE, "agent");
            xb_add(&bar[XB_XGEN(b.x)], 1u);
            asm volatile("s_waitcnt vmcnt(0)" ::: "memory");
        } else {
            XB_SPIN(xb_ld(&bar[XB_XGEN(b.x)]) == gen, bar);
            __builtin_amdgcn_fence(__ATOMIC_ACQUIRE, "agent");
            asm volatile("s_waitcnt vmcnt(0)" ::: "memory");
        }
    }
    __syncthreads();
}
struct Args { const void* in[27]; float* out; unsigned char* ws; };
#define INF(i) ((const float*)args.in[i])
#define WSP(T, off) ((T*)(F.ws + (off)))
constexpr int NWAVES = 8;
constexpr int RING_OFF = 0, RING_BYTES = 131072;
constexpr int LDSCTL_OFF = RING_BYTES, MISC_OFF = LDSCTL_OFF + 320;
constexpr int LDS_BYTES = 147456;
static_assert(MISC_OFF + 128 <= LDS_BYTES, "LDS map");

struct Frame {
    LAS unsigned char* lds;
    volatile LAS unsigned* MISC;
    gu32* ctl;
    int tid, lane, wave, vcu, G;
    unsigned char* ws; float* out;
};

__device__ __forceinline__ int t5_bucket(int n) {
    if (n < 16) return n;
    const int b = 16 + (int)(__logf((float)n * (1.0f / 16.0f)) * (16.0f / 2.0794415416798357f));
    return b < 31 ? b : 31;
}

__device__ __forceinline__ void tr_item(const float* W, int ldw, int k0, int c0, const float* gain, bf16_t* WT, int ldt, int r0, LAS float* scr, int lane, float gscale = 1.0f) {
    if (c0 >= 0) {
#pragma unroll 8
        for (int i = 0; i < 32; ++i) { const int kk = 2 * i + (lane >> 5); float v = W[(size_t)(k0 + kk) * ldw + c0 + (lane & 31)]; if (gain) v *= gain[k0 + kk]; scr[kk * 33 + (lane & 31)] = v * gscale; }
    } else {
#pragma unroll 8
        for (int i = 0; i < 32; ++i) { const int kk = 2 * i + (lane >> 5); scr[kk * 33 + (lane & 31)] = 0.f; }
    }
    LDS_WAIT(); asm volatile("" ::: "memory");
    const int c = lane & 7;
#pragma unroll
    for (int j = 0; j < 4; ++j) { const int n = (lane >> 3) + 8 * j; const LAS float* s = scr + (8 * c) * 33 + n;
        u32x4 o; o.x = pk2(s[0 * 33], s[1 * 33]); o.y = pk2(s[2 * 33], s[3 * 33]); o.z = pk2(s[4 * 33], s[5 * 33]); o.w = pk2(s[6 * 33], s[7 * 33]);
        *(u32x4*)(WT + (size_t)(r0 + n) * ldt + k0 + 8 * c) = o; }
    LDS_WAIT(); asm volatile("" ::: "memory");
}
__device__ __forceinline__ void sincos_d(double a, float& s, float& c) {
    const double q = __builtin_rint(a * 0.6366197723675814);
    double r = __builtin_fma(-q, 1.5707963267948966, a); r = __builtin_fma(-q, 6.123233995736766e-17, r);
    const double r2 = r * r;
    double sp = 1.0 / 6227020800.0; sp = sp * r2 - 1.0 / 39916800.0; sp = sp * r2 + 1.0 / 362880.0; sp = sp * r2 - 1.0 / 5040.0; sp = sp * r2 + 1.0 / 120.0; sp = sp * r2 - 1.0 / 6.0; sp = sp * r2 + 1.0; sp *= r;
    double cp = -1.0 / 87178291200.0; cp = cp * r2 + 1.0 / 479001600.0; cp = cp * r2 - 1.0 / 3628800.0; cp = cp * r2 + 1.0 / 40320.0; cp = cp * r2 - 1.0 / 720.0; cp = cp * r2 + 1.0 / 24.0; cp = cp * r2 - 0.5; cp = cp * r2 + 1.0;
    const int qi = (int)q & 3;
    const double ss = (qi == 0) ? sp : (qi == 1) ? cp : (qi == 2) ? -sp : -cp;
    const double cc = (qi == 0) ? cp : (qi == 1) ? -sp : (qi == 2) ? -cp : sp;
    s = (float)ss; c = (float)cc;
}
__device__ __forceinline__ void p0_prologue(Frame& F, const Args& args) {
    LAS float* scr = (LAS float*)(F.lds + RING_OFF + F.wave * 16384);
    const int gw = F.vcu * NWAVES + F.wave, NGW = F.G * NWAVES;
    constexpr int I13 = (D / 64) * (2 * FF / 32), I2 = (FF / 64) * (D / 32), IIN = (D / 64) * (ZLD / 32), IUQ = (QLORA / 64) * (QLD / 32), IUKV = (KVLORA / 64) * (2 * KLD / 32),
                  IOUT = (D / 64) * (D / 32), IG = IOUT, IPLE = (PLE / 64) * (D / 32);
    constexpr int NITEMS = 2 * I13 + 2 * I2 + IIN + IUQ + IUKV + IOUT + IG + IPLE;
    for (int it = gw; it < NITEMS; it += NGW) {
        int r = it;
        if (r < 2 * I13) {
            const bool second = r >= I13; if (second) r -= I13;
            const int nblk = 2 * FF / 32, kb = r / nblk, nb = r % nblk, j = nb >> 3, w = nb & 7, b = w >> 2, i0 = (w & 3) * 32;
            const float* src = INF(second ? (b ? 21 : 20) : (b ? 7 : 6));
            tr_item(src, FF, 64 * kb, 128 * j + i0, nullptr, WSP(bf16_t, second ? WS_W13B : WS_W13A), D, 32 * nb, scr, F.lane); continue; }
        r -= 2 * I13;
        if (r < 2 * I2) { const bool second = r >= I2; if (second) r -= I2;
            const int nblk = D / 32, kb = r / nblk, nb = r % nblk;
            tr_item(INF(second ? 22 : 8), D, 64 * kb, 32 * nb, nullptr, WSP(bf16_t, second ? WS_W2B : WS_W2A), FF, 32 * nb, scr, F.lane); continue; }
        r -= 2 * I2;
        if (r < IIN) { const int nblk = ZLD / 32, kb = r / nblk, nb = r % nblk, r0 = 32 * nb;
            int c0;
            if (r0 < 1024) c0 = r0; else if (r0 < 2048) c0 = 1088 + (r0 - 1024); else if (r0 < 2304) c0 = 2112 + (r0 - 2048); else if (r0 == 2304) c0 = 1024; else if (r0 == 2432) c0 = 1056; else c0 = -1;
            tr_item(INF(9), DIN, 64 * kb, c0, nullptr, WSP(bf16_t, WS_WIN), D, r0, scr, F.lane, (r0 >= 1024 && r0 < 2048) ? SWA_SCALE2 : 1.0f); continue; }
        r -= IIN;
        if (r < IUQ) { const int nblk = QLD / 32, kb = r / nblk, nb = r % nblk, r0 = 32 * nb;
            int c0;
            if (r0 < 1024) c0 = QKD * (r0 >> 7) + (r0 & 127);
            else { const int t = (r0 - 1024) >> 8, b = ((r0 - 1024) >> 7) & 1, w = (r0 & 127) >> 5; c0 = QKD * (4 * t + w) + NOPE + 32 * b; }
            tr_item(INF(11), QLD, 64 * kb, c0, INF(10), WSP(bf16_t, WS_WUQ), QLORA, r0, scr, F.lane); continue; }
        r -= IUQ;
        if (r < IUKV) { const int nblk = 2 * KLD / 32, kb = r / nblk, nb = r % nblk;
            tr_item(INF(13), 2 * KLD, 64 * kb, 32 * nb, INF(12), WSP(bf16_t, WS_WUKV), KVLORA, 32 * nb, scr, F.lane); continue; }
        r -= IUKV;
        if (r < IOUT) { const int nblk = D / 32, kb = r / nblk, nb = r % nblk, k0 = 64 * kb;
            tr_item(INF(17), D, k0, 32 * nb, k0 < 1024 ? INF(15) : INF(16) - 1024, WSP(bf16_t, WS_WOUT), D, 32 * nb, scr, F.lane); continue; }
        r -= IOUT;
        if (r < IG) { const int nblk = D / 32, kb = r / nblk, nb = r % nblk;
            tr_item(INF(25), D, 64 * kb, 32 * nb, nullptr, WSP(bf16_t, WS_WG), D, 32 * nb, scr, F.lane); continue; }
        r -= IG;
        { const int nblk = D / 32, kb = r / nblk, nb = r % nblk;
            tr_item(INF(26), D, 64 * kb, 32 * nb, nullptr, WSP(bf16_t, WS_WPLE), PLE, 32 * nb, scr, F.lane); }
    }
    const int gt = F.vcu * (NWAVES * 64) + F.tid, NGT = F.G * NWAVES * 64;
    for (int i = gt; i < M * D / 8; i += NGT) { const f32x4 a = ((const f32x4*)INF(0))[2 * i], b = ((const f32x4*)INF(0))[2 * i + 1];
        u32x4 o; o.x = pk2(a[0], a[1]); o.y = pk2(a[2], a[3]); o.z = pk2(b[0], b[1]); o.w = pk2(b[2], b[3]); ((u32x4*)WSP(bf16_t, WS_HB))[i] = o; }
    for (int i = gt; i < M * PLE / 8; i += NGT) { const f32x4 a = ((const f32x4*)INF(1))[2 * i], b = ((const f32x4*)INF(1))[2 * i + 1];
        u32x4 o; o.x = pk2(a[0], a[1]); o.y = pk2(a[2], a[3]); o.z = pk2(b[0], b[1]); o.w = pk2(b[2], b[3]); ((u32x4*)WSP(bf16_t, WS_PB))[i] = o; }
    for (int i = gt; i < M * 32; i += NGT) { const int row = i >> 5, fi = i & 31; double fr = 1.0; for (int k = 0; k < fi; ++k) fr *= 0.7498942093324559;
        float s, c; sincos_d((double)((const int*)args.in[2])[row] * fr, s, c); WSP(float, WS_COS)[i] = c; WSP(float, WS_SIN)[i] = s; }
    for (int i = gt; i < SWH * WINDOW; i += NGT) { const int h = i >> 7, dist = i & 127; WSP(float, WS_BIAS)[i] = INF(3)[t5_bucket(dist) * SWH + h] * LOG2E; }
}

__device__ __forceinline__ void ln_pass(Frame& F, float* io, const float* g, const float* b, bf16_t* hb) {
    const int gw = F.vcu * NWAVES + F.wave, NGW = F.G * NWAVES;
    for (int m = gw; m < M; m += NGW) {
        f32x4* xr = (f32x4*)(io + (size_t)m * D) + F.lane;
        f32x4 v[8]; float s = 0.f;
#pragma unroll
        for (int j = 0; j < 8; ++j) { v[j] = xr[64 * j]; s += (v[j][0] + v[j][1]) + (v[j][2] + v[j][3]); }
        const float mean = wave_sum(s) * (1.0f / D); float s2 = 0.f;
#pragma unroll
        for (int j = 0; j < 8; ++j) { v[j] = v[j] - mean; s2 += (v[j][0] * v[j][0] + v[j][1] * v[j][1]) + (v[j][2] * v[j][2] + v[j][3] * v[j][3]); }
        const float rstd = 1.0f / sqrtf(wave_sum(s2) * (1.0f / D) + LN_EPS);
        u32x2* o8 = (u32x2*)(hb + (size_t)m * D) + F.lane;
#pragma unroll
        for (int j = 0; j < 8; ++j) { const f32x4 gg = ((const f32x4*)g)[F.lane + 64 * j], bb = ((const f32x4*)b)[F.lane + 64 * j]; const f32x4 o = v[j] * rstd * gg + bb;
            xr[64 * j] = o; u32x2 w; w.x = pk2(o[0], o[1]); w.y = pk2(o[2], o[3]); o8[64 * j] = w; }
    }
}
__device__ __forceinline__ void norm_mix_pass(Frame& F) {
    const int gw = F.vcu * NWAVES + F.wave, NGW = F.G * NWAVES;
    for (int m = gw; m < M; m += NGW) {
        u32x4* ar = (u32x4*)(WSP(bf16_t, WS_AMIX) + (size_t)m * D) + F.lane;
        float v[4][8]; float s[2] = {0.f, 0.f};
#pragma unroll
        for (int j = 0; j < 4; ++j) { const u32x4 w = ar[64 * j];
#pragma unroll
            for (int e = 0; e < 4; ++e) { v[j][2 * e] = __uint_as_float(w[e] << 16); v[j][2 * e + 1] = __uint_as_float(w[e] & 0xffff0000u); }
#pragma unroll
            for (int e = 0; e < 8; ++e) s[j >> 1] += v[j][e] * v[j][e]; }
        const float r0 = 1.0f / sqrtf(wave_sum(s[0]) * (1.0f / 1024.0f) + LN_EPS), r1 = 1.0f / sqrtf(wave_sum(s[1]) * (1.0f / 1024.0f) + LN_EPS);
#pragma unroll
        for (int j = 0; j < 4; ++j) { const float r = (j < 2) ? r0 : r1; u32x4 w;
#pragma unroll
            for (int e = 0; e < 4; ++e) w[e] = pk2(v[j][2 * e] * r, v[j][2 * e + 1] * r);
            ar[64 * j] = w; }
    }
}

__device__ __forceinline__ void mla_attn_naive(Frame& F) {
    LAS float* qs = (LAS float*)(F.lds + F.wave * 8192); LAS float* sc = qs + 256;
    const int gw = F.vcu * NWAVES + F.wave, NGW = F.G * NWAVES, lane = F.lane;
    for (int task = gw; task < M * NH; task += NGW) {
        const int head = task & 7, q = task >> 3;
        const bf16_t* qp = WSP(bf16_t, WS_Q) + (size_t)q * QLD + head * QKD;
        asm volatile("" ::: "memory");
#pragma unroll
        for (int j = 0; j < 3; ++j) qs[lane + 64 * j] = bf2f(qp[lane + 64 * j]);
        LDS_WAIT(); asm volatile("" ::: "memory");
        float m = -INFINITY, l = 0.f, a0 = 0.f, a1 = 0.f;
        for (int c0 = 0; c0 <= q; c0 += 1024) {
            const int nk = (q + 1 - c0) < 1024 ? (q + 1 - c0) : 1024;
            float cmax = -INFINITY;
            for (int kk = lane; kk < nk; kk += 64) {
                const int key = c0 + kk;
                const bf16_t* kp = WSP(bf16_t, WS_K) + (size_t)key * KLD + head * NOPE; const bf16_t* rp = WSP(bf16_t, WS_KR) + (size_t)key * 64;
                float s = 0.f;
                for (int c = 0; c < 16; ++c) { const bf16x8 kv = *(const bf16x8*)(kp + 8 * c);
#pragma unroll
                    for (int e = 0; e < 8; ++e) s += qs[8 * c + e] * bf2f((bf16_t)kv[e]); }
                for (int c = 0; c < 8; ++c) { const bf16x8 kv = *(const bf16x8*)(rp + 8 * c);
#pragma unroll
                    for (int e = 0; e < 8; ++e) s += qs[NOPE + 8 * c + e] * bf2f((bf16_t)kv[e]); }
                sc[kk] = s; cmax = fmaxf(cmax, s);
            }
            cmax = wave_max(cmax);
            const float mn = fmaxf(m, cmax), f = exp2f(m - mn);
            l *= f; a0 *= f; a1 *= f; m = mn;
            float ps = 0.f;
            for (int kk = lane; kk < nk; kk += 64) { const float pv = exp2f(sc[kk] - mn); sc[kk] = pv; ps += pv; }
            l += wave_sum(ps);
            LDS_WAIT(); asm volatile("" ::: "memory");
            const bf16_t* vp = WSP(bf16_t, WS_V) + (size_t)c0 * KLD + head * VD + 2 * lane;
            int kk = 0;
            for (; kk + 8 <= nk; kk += 8) { unsigned vv[8];
#pragma unroll
                for (int e = 0; e < 8; ++e) vv[e] = *(const unsigned*)(vp + (size_t)(kk + e) * KLD);
#pragma unroll
                for (int e = 0; e < 8; ++e) { const float pv = sc[kk + e]; a0 += pv * __uint_as_float(vv[e] << 16); a1 += pv * __uint_as_float(vv[e] & 0xffff0000u); } }
            for (; kk < nk; ++kk) { const float pv = sc[kk]; const unsigned vv = *(const unsigned*)(vp + (size_t)kk * KLD); a0 += pv * __uint_as_float(vv << 16); a1 += pv * __uint_as_float(vv & 0xffff0000u); }
            LDS_WAIT(); asm volatile("" ::: "memory");
        }
        const float il = 1.0f / l;
        *(unsigned*)(WSP(bf16_t, WS_AMIX) + (size_t)q * D + head * VD + 2 * lane) = pk2(a0 * il, a1 * il);
    }
}
__device__ __forceinline__ void swa_attn_naive(Frame& F, const Args& args) {
    LAS float* qs = (LAS float*)(F.lds + F.wave * 8192); LAS float* sc = qs + 256;
    const int gw = F.vcu * NWAVES + F.wave, NGW = F.G * NWAVES, lane = F.lane;
    for (int task = gw; task < M * SWH; task += NGW) {
        const int h = task & 15, q = task >> 4, kvh = h >> 3;
        asm volatile("" ::: "memory");
        qs[lane] = bf2f(WSP(bf16_t, WS_Z)[(size_t)q * ZLD + Z_QS + h * SWD + lane]);
        LDS_WAIT(); asm volatile("" ::: "memory");
        float sv[2];
#pragma unroll
        for (int t = 0; t < 2; ++t) { const int dist = lane + 64 * t, key = q - dist; float s = -INFINITY;
            if (key >= 0) { const bf16_t* kp = WSP(bf16_t, WS_Z) + (size_t)key * ZLD + Z_KS + kvh * SWD; float d = 0.f;
                for (int c = 0; c < 8; ++c) { const bf16x8 kv = *(const bf16x8*)(kp + 8 * c);
#pragma unroll
                    for (int e = 0; e < 8; ++e) d += qs[8 * c + e] * bf2f((bf16_t)kv[e]); }
                s = d + WSP(float, WS_BIAS)[h * WINDOW + dist]; }
            sv[t] = s; }
        const float sink2 = INF(14)[h] * LOG2E;
        const float mx = fmaxf(wave_max(fmaxf(sv[0], sv[1])), sink2);
        const float e0 = exp2f(sv[0] - mx), e1 = exp2f(sv[1] - mx);
        sc[lane] = e0; sc[lane + 64] = e1;
        const float denom = wave_sum(e0 + e1) + exp2f(sink2 - mx);
        LDS_WAIT(); asm volatile("" ::: "memory");
        float acc = 0.f;
        const int nd = (q + 1) < WINDOW ? (q + 1) : WINDOW;
        int dist = 0;
        for (; dist + 8 <= nd; dist += 8) { bf16_t vv[8];
#pragma unroll
            for (int e = 0; e < 8; ++e) vv[e] = WSP(bf16_t, WS_Z)[(size_t)(q - dist - e) * ZLD + Z_VS + kvh * SWD + lane];
#pragma unroll
            for (int e = 0; e < 8; ++e) acc += sc[dist + e] * bf2f(vv[e]); }
        for (; dist < nd; ++dist) acc += sc[dist] * bf2f(WSP(bf16_t, WS_Z)[(size_t)(q - dist) * ZLD + Z_VS + kvh * SWD + lane]);
        WSP(bf16_t, WS_AMIX)[(size_t)q * D + 1024 + h * SWD + lane] = (bf16_t)f2bf(acc / denom);
        LDS_WAIT(); asm volatile("" ::: "memory");
    }
}
namespace mla {
typedef float f32x16 __attribute__((ext_vector_type(16)));
typedef short s16x4 __attribute__((ext_vector_type(4)));
typedef short v4i16_t __attribute__((ext_vector_type(4)));
constexpr int SLOT = 40960, KPART = 24576;
constexpr float THR = 8.0f;
__device__ __forceinline__ int crow(int r, int hi) { return (r & 3) + 8 * (r >> 2) + 4 * hi; }
__device__ __forceinline__ void glds16(const void* gsrc, unsigned lds_dst) { unsigned keep;
    asm volatile("s_mov_b32 %0, m0\n\ts_mov_b32 m0, %2\n\ts_nop 0\n\tglobal_load_lds_dwordx4 %1, off\n\ts_mov_b32 m0, %0" : "=&s"(keep) : "v"(gsrc), "s"(lds_dst) : "memory"); }
__device__ __forceinline__ void glds16s(const char* sbase, unsigned voff, unsigned lds_dst) { unsigned keep;
    asm volatile("s_mov_b32 %0, m0\n\ts_mov_b32 m0, %3\n\ts_nop 0\n\tglobal_load_lds_dwordx4 %1, %2\n\ts_mov_b32 m0, %0" : "=&s"(keep) : "v"(voff), "s"(sbase), "s"(lds_dst) : "memory"); }
__device__ __forceinline__ s16x4 vtr(const LAS unsigned char* p) { return __builtin_bit_cast(s16x4, __builtin_amdgcn_ds_read_tr16_b64_v4i16((LAS v4i16_t*)p)); }
__device__ __forceinline__ float swapmax(float v) { auto rr = __builtin_amdgcn_permlane32_swap(__float_as_uint(v), __float_as_uint(v), false, false); return fmaxf(__uint_as_float(rr[0]), __uint_as_float(rr[1])); }
__device__ __forceinline__ float swapsum(float v) { auto rr = __builtin_amdgcn_permlane32_swap(__float_as_uint(v), __float_as_uint(v), false, false); return __uint_as_float(rr[0]) + __uint_as_float(rr[1]); }
#define MLA_WAIT_BAR(N) asm volatile("s_waitcnt vmcnt(" #N ") lgkmcnt(0)\n\ts_barrier" ::: "memory")
#define MLA_LBAR() asm volatile("s_waitcnt lgkmcnt(0)\n\ts_barrier" ::: "memory")

__device__ __forceinline__ void unit(const bf16_t* __restrict__ Q, const bf16_t* __restrict__ K, const bf16_t* __restrict__ KR, const bf16_t* __restrict__ V, bf16_t* __restrict__ O, int head, int qb, LAS unsigned char* lds) {
    const int tid = opaque_tid(), lane = tid & 63, r32 = lane & 31, hi = lane >> 5;
    const int wid = __builtin_amdgcn_readfirstlane(tid >> 6), rg = wid & 3, kh = wid >> 2;
    const int q_rel = 32 * rg + r32, q_abs = 128 * qb + q_rel, NT = 2 * (qb + 1);
    const unsigned lds0 = (unsigned)(uintptr_t)lds;
    bf16x8 qr[12];
    { const bf16_t* qp = Q + (size_t)q_abs * QLD + head * QKD + 8 * hi;
#pragma unroll
      for (int s = 0; s < 12; ++s) qr[s] = *(const bf16x8*)(qp + 16 * s); }
#pragma unroll
    for (int s = 0; s < 12; ++s) asm volatile("" : "+v"(qr[s]));
    asm volatile("s_waitcnt vmcnt(0)" ::: "memory");
    const unsigned voffK = (unsigned)lane * (KLD * 2), voffR = (unsigned)lane * (ROPE * 2), voffV = (unsigned)(lane >> 2) * (KLD * 2) + (unsigned)(lane & 3) * 16;
    const char* const Kh = (const char*)(K + head * NOPE); const char* const Vh = (const char*)(V + head * VD); const char* const Rh = (const char*)KR;
#define MLA_DMA(t, slotoff) do { \
        _Pragma("unroll") for (int i_ = 0; i_ < 3; ++i_) { const int c_ = 3 * wid + i_; \
            if (c_ < 16) glds16s(Kh + (size_t)(t) * (64 * KLD * 2) + 16 * c_, voffK, lds0 + c_ * 1024 + (slotoff)); \
            else         glds16s(Rh + (size_t)(t) * (64 * ROPE * 2) + 16 * (c_ - 16), voffR, lds0 + c_ * 1024 + (slotoff)); } \
        _Pragma("unroll") for (int i_ = 0; i_ < 2; ++i_) { const int pv_ = 2 * wid + i_, db_ = pv_ >> 2, kg_ = pv_ & 3; \
            glds16s(Vh + (size_t)(t) * (64 * KLD * 2) + (size_t)(16 * kg_) * (KLD * 2) + 64 * db_, voffV, lds0 + KPART + pv_ * 1024 + (slotoff)); } } while (0)
    MLA_DMA(0, 0); MLA_DMA(1, SLOT);
    const LAS unsigned char* kb0 = lds + hi * 1024 + (32 * kh + r32) * 16;
    const LAS unsigned char* vb0 = lds + KPART + 2 * kh * 1024 + ((lane >> 4) & 1) * 32 + (lane & 3) * 8 + (4 * hi + ((lane & 15) >> 2)) * 64;
    float m = -1.0e30f, l = 0.f;
    f32x16 o[4];
#pragma unroll
    for (int d = 0; d < 4; ++d)
#pragma unroll
        for (int i = 0; i < 16; ++i) o[d][i] = 0.f;
    int slot = 0, slot2 = 2 * SLOT;
    for (int t = 0; t < NT; ++t) {
        if (t + 1 < NT) MLA_WAIT_BAR(5); else MLA_WAIT_BAR(0);
        if (t + 2 < NT) MLA_DMA(t + 2, slot2);
        f32x16 p;
#pragma unroll
        for (int i = 0; i < 16; ++i) p[i] = 0.f;
        { const LAS unsigned char* kb = kb0 + slot;
#pragma unroll
          for (int s = 0; s < 12; ++s) { const bf16x8 kf = *(const LAS bf16x8*)(kb + s * 2048); p = __builtin_amdgcn_mfma_f32_32x32x16_bf16(kf, qr[s], p, 0, 0, 0); } }
        if (t >= NT - 2) { const int kbase = 64 * (t - (NT - 2)) + 32 * kh + 4 * hi;
#pragma unroll
            for (int i = 0; i < 16; ++i) { const int key_rel = kbase + (i & 3) + 8 * (i >> 2); if (key_rel > q_rel) p[i] = -INFINITY; } }
        float mloc = fmaxf(fmaxf(p[0], p[1]), fmaxf(p[2], p[3]));
#pragma unroll
        for (int i = 4; i < 16; i += 4) mloc = fmaxf(mloc, fmaxf(fmaxf(p[i], p[i + 1]), fmaxf(p[i + 2], p[i + 3])));
        mloc = swapmax(mloc);
        if (__any(mloc > m + THR)) { const float mn = fmaxf(m, mloc), f = __builtin_amdgcn_exp2f(m - mn); m = mn; l *= f;
#pragma unroll
            for (int d = 0; d < 4; ++d)
#pragma unroll
                for (int i = 0; i < 16; ++i) o[d][i] *= f; }
        float ps = 0.f;
#pragma unroll
        for (int i = 0; i < 16; ++i) { p[i] = __builtin_amdgcn_exp2f(p[i] - m); ps += p[i]; }
        l += ps;
        u32x4 pw0, pw1;
        pw0.x = pg8::cvt_pk_bf16(p[0], p[1]); pw0.y = pg8::cvt_pk_bf16(p[2], p[3]); pw0.z = pg8::cvt_pk_bf16(p[4], p[5]); pw0.w = pg8::cvt_pk_bf16(p[6], p[7]);
        pw1.x = pg8::cvt_pk_bf16(p[8], p[9]); pw1.y = pg8::cvt_pk_bf16(p[10], p[11]); pw1.z = pg8::cvt_pk_bf16(p[12], p[13]); pw1.w = pg8::cvt_pk_bf16(p[14], p[15]);
        const bf16x8 pb0 = __builtin_bit_cast(bf16x8, pw0), pb1 = __builtin_bit_cast(bf16x8, pw1);
        { const LAS unsigned char* vb = vb0 + slot;
#pragma unroll
          for (int d = 0; d < 4; ++d) {
              const s16x4 l0 = vtr(vb + d * 4096), h0 = vtr(vb + d * 4096 + 512), l1 = vtr(vb + d * 4096 + 1024), h1 = vtr(vb + d * 4096 + 1536);
              const bf16x8 v0 = (bf16x8){l0[0], l0[1], l0[2], l0[3], h0[0], h0[1], h0[2], h0[3]}, v1 = (bf16x8){l1[0], l1[1], l1[2], l1[3], h1[0], h1[1], h1[2], h1[3]};
              o[d] = __builtin_amdgcn_mfma_f32_32x32x16_bf16(v0, pb0, o[d], 0, 0, 0);
              o[d] = __builtin_amdgcn_mfma_f32_32x32x16_bf16(v1, pb1, o[d], 0, 0, 0); } }
        slot = (slot == 2 * SLOT) ? 0 : slot + SLOT; slot2 = (slot2 == 2 * SLOT) ? 0 : slot2 + SLOT;
    }
#undef MLA_DMA
    l = swapsum(l);
    MLA_LBAR();
    LAS float* X = (LAS float*)lds + wid * 2048; LAS float* Y = (LAS float*)(lds + 65536);
#pragma unroll
    for (int d = 0; d < 2; ++d)
#pragma unroll
        for (int i = 0; i < 16; ++i) X[(d * 16 + i) * 64 + lane] = kh ? o[d][i] : o[2 + d][i];
    Y[wid * 64 + lane] = m; Y[512 + wid * 64 + lane] = l;
    MLA_LBAR();
    { const int wp = wid ^ 4; const LAS float* Xp = (const LAS float*)lds + wp * 2048;
      const float mp = Y[wp * 64 + lane], lp = Y[512 + wp * 64 + lane];
      const float mx = fmaxf(m, mp); float a = __builtin_amdgcn_exp2f(m - mx), ap = __builtin_amdgcn_exp2f(mp - mx);
      const float inv = 1.0f / (l * a + lp * ap); a *= inv; ap *= inv;
      bf16_t* op = O + (size_t)q_abs * D + head * VD + (kh ? 64 : 0) + 4 * hi;
#pragma unroll
      for (int d = 0; d < 2; ++d)
#pragma unroll
          for (int g = 0; g < 4; ++g) { float r[4];
#pragma unroll
              for (int e = 0; e < 4; ++e) { const int i = 4 * g + e; const float mine = kh ? o[2 + d][i] : o[d][i]; r[e] = mine * a + Xp[(d * 16 + i) * 64 + lane] * ap; }
              u32x2 w; w.x = pg8::cvt_pk_bf16(r[0], r[1]); w.y = pg8::cvt_pk_bf16(r[2], r[3]);
              *(u32x2*)(op + 32 * d + 8 * g) = w; } }
    MLA_LBAR();
}
#undef MLA_WAIT_BAR
#undef MLA_LBAR
}
__device__ __forceinline__ void mla_attn_phase(Frame& F) {
    const bf16_t* Q = WSP(bf16_t, WS_Q); const bf16_t* K = WSP(bf16_t, WS_K); const bf16_t* KR = WSP(bf16_t, WS_KR); const bf16_t* V = WSP(bf16_t, WS_V); bf16_t* O = WSP(bf16_t, WS_AMIX);
    for (int pr = F.vcu; pr < 256; pr += F.G) { const int head = pr >> 5, s = pr & 31;
        mla::unit(Q, K, KR, V, O, head, 63 - s, F.lds);
        mla::unit(Q, K, KR, V, O, head, s, F.lds); }
}
namespace swa {
using mla::f32x16; using mla::s16x4; using mla::crow; using mla::glds16s; using mla::vtr; using mla::swapmax; using mla::swapsum;
constexpr int VPART = 32768, BT_OFF = 65536;
__device__ __forceinline__ void unit(const bf16_t* __restrict__ Z, const float* __restrict__ biasT, const float* __restrict__ sinks, bf16_t* __restrict__ O, int kvh, int n, int hh, LAS unsigned char* lds) {
    const int tid = opaque_tid(), lane = tid & 63, r32 = lane & 31, hi = lane >> 5;
    const int wid = __builtin_amdgcn_readfirstlane(tid >> 6), g = 4 * hh + (wid & 3), h = 8 * kvh + g, rh = wid >> 2;
    const unsigned lds0 = (unsigned)(uintptr_t)lds;
    { const unsigned voffK = (unsigned)lane * (ZLD * 2), voffV = (unsigned)(lane >> 2) * (ZLD * 2) + (unsigned)(lane & 3) * 16;
#pragma unroll
      for (int i = 0; i < 8; ++i) { const int pc = (wid & 3) * 8 + i;
          if (wid < 4) { const int c = pc >> 2, kq = pc & 3, j0 = 64 * kq; const int key0 = (n > 0 || j0 >= 128) ? 128 * (n - 1) + j0 : j0;
              glds16s((const char*)(Z + (size_t)key0 * ZLD + Z_KS + kvh * SWD + 8 * c), voffK, lds0 + c * 4096 + kq * 1024); }
          else { const int db = pc >> 4, kg = pc & 15, j0 = 16 * kg; const int key0 = (n > 0 || j0 >= 128) ? 128 * (n - 1) + j0 : j0;
              glds16s((const char*)(Z + (size_t)key0 * ZLD + Z_VS + kvh * SWD + 32 * db), voffV, lds0 + VPART + pc * 1024); } } }
    LAS float* bt = (LAS float*)(lds + BT_OFF) + wid * 192;
#pragma unroll
    for (int j = 0; j < 3; ++j) { const int dist = lane + 64 * j - 32; bt[lane + 64 * j] = (dist >= 0 && dist < WINDOW) ? biasT[h * WINDOW + dist] : 0.f; }
    const float sink2 = sinks[h] * LOG2E;
    asm volatile("s_waitcnt vmcnt(0) lgkmcnt(0)\n\ts_barrier" ::: "memory");
    const LAS unsigned char* kb0 = lds + hi * 4096 + r32 * 16;
    const LAS unsigned char* vb0 = lds + VPART + ((lane >> 4) & 1) * 32 + (lane & 3) * 8 + (4 * hi + ((lane & 15) >> 2)) * 64;
    const LAS float* btl = bt + 32 + r32 - 4 * hi;
    for (int rgl = 0; rgl < 2; ++rgl) {
        const int rg = 2 * rh + rgl, q_abs = 128 * n + 32 * rg + r32;
        bf16x8 qf[4];
        { const bf16_t* qp = Z + (size_t)q_abs * ZLD + Z_QS + h * SWD + 8 * hi;
#pragma unroll
          for (int s = 0; s < 4; ++s) qf[s] = *(const bf16x8*)(qp + 16 * s); }
        f32x16 sc[5];
#pragma unroll
        for (int tj = 0; tj < 5; ++tj) {
#pragma unroll
            for (int i = 0; i < 16; ++i) sc[tj][i] = 0.f;
            const LAS unsigned char* kb = kb0 + (rg + tj) * 512;
#pragma unroll
            for (int s = 0; s < 4; ++s) { const bf16x8 kf = *(const LAS bf16x8*)(kb + s * 8192); sc[tj] = __builtin_amdgcn_mfma_f32_32x32x16_bf16(kf, qf[s], sc[tj], 0, 0, 0); } }
        float mx = sink2;
#pragma unroll
        for (int tj = 0; tj < 5; ++tj) { const bool dead = (n == 0) && (rg + tj < 4);
#pragma unroll
            for (int i = 0; i < 16; ++i) { const int cr = (i & 3) + 8 * (i >> 2); float v = sc[tj][i] + btl[32 * (4 - tj) - cr];
                const int dd = r32 - cr - 4 * hi;
                if (tj == 0 && dd >= 0) v = -INFINITY;
                if (tj == 4 && dd < 0) v = -INFINITY;
                if (dead) v = -INFINITY;
                sc[tj][i] = v; mx = fmaxf(mx, v); } }
        mx = swapmax(mx);
        float ps = 0.f;
#pragma unroll
        for (int tj = 0; tj < 5; ++tj)
#pragma unroll
            for (int i = 0; i < 16; ++i) { const float e = __builtin_amdgcn_exp2f(sc[tj][i] - mx); sc[tj][i] = e; ps += e; }
        const float inv = 1.0f / (swapsum(ps) + __builtin_amdgcn_exp2f(sink2 - mx));
        f32x16 o[2];
#pragma unroll
        for (int d = 0; d < 2; ++d)
#pragma unroll
            for (int i = 0; i < 16; ++i) o[d][i] = 0.f;
#pragma unroll
        for (int tj = 0; tj < 5; ++tj) {
            u32x4 pw0, pw1;
            pw0.x = pg8::cvt_pk_bf16(sc[tj][0], sc[tj][1]); pw0.y = pg8::cvt_pk_bf16(sc[tj][2], sc[tj][3]); pw0.z = pg8::cvt_pk_bf16(sc[tj][4], sc[tj][5]); pw0.w = pg8::cvt_pk_bf16(sc[tj][6], sc[tj][7]);
            pw1.x = pg8::cvt_pk_bf16(sc[tj][8], sc[tj][9]); pw1.y = pg8::cvt_pk_bf16(sc[tj][10], sc[tj][11]); pw1.z = pg8::cvt_pk_bf16(sc[tj][12], sc[tj][13]); pw1.w = pg8::cvt_pk_bf16(sc[tj][14], sc[tj][15]);
            const bf16x8 pb0 = __builtin_bit_cast(bf16x8, pw0), pb1 = __builtin_bit_cast(bf16x8, pw1);
            const LAS unsigned char* vb = vb0 + (rg + tj) * 2048;
#pragma unroll
            for (int d = 0; d < 2; ++d) {
                const s16x4 l0 = vtr(vb + d * 16384), h0 = vtr(vb + d * 16384 + 512), l1 = vtr(vb + d * 16384 + 1024), h1 = vtr(vb + d * 16384 + 1536);
                const bf16x8 v0 = (bf16x8){l0[0], l0[1], l0[2], l0[3], h0[0], h0[1], h0[2], h0[3]}, v1 = (bf16x8){l1[0], l1[1], l1[2], l1[3], h1[0], h1[1], h1[2], h1[3]};
                o[d] = __builtin_amdgcn_mfma_f32_32x32x16_bf16(v0, pb0, o[d], 0, 0, 0);
                o[d] = __builtin_amdgcn_mfma_f32_32x32x16_bf16(v1, pb1, o[d], 0, 0, 0); } }
        bf16_t* op = O + (size_t)q_abs * D + 1024 + h * SWD + 4 * hi;
#pragma unroll
        for (int d = 0; d < 2; ++d)
#pragma unroll
            for (int gq = 0; gq < 4; ++gq) { u32x2 w; w.x = pg8::cvt_pk_bf16(o[d][4 * gq] * inv, o[d][4 * gq + 1] * inv); w.y = pg8::cvt_pk_bf16(o[d][4 * gq + 2] * inv, o[d][4 * gq + 3] * inv);
                *(u32x2*)(op + 32 * d + 8 * gq) = w; }
    }
    asm volatile("s_waitcnt lgkmcnt(0)\n\ts_barrier" ::: "memory");
}
}
__device__ __forceinline__ void swa_attn_phase(Frame& F, const Args& args) {
    const bf16_t* Z = WSP(bf16_t, WS_Z); bf16_t* O = WSP(bf16_t, WS_AMIX);
    for (int u = F.vcu; u < 256; u += F.G) { const int kvh = u >> 7, hh = (u >> 6) & 1, n = u & 63;
        swa::unit(Z, WSP(float, WS_BIAS), INF(14), O, kvh, n, hh, F.lds); }
}
#ifndef STOP_AFTER
#define STOP_AFTER 99
#endif
#ifndef FAST_MLA
#define FAST_MLA 1
#endif
#ifndef FAST_SWA
#define FAST_SWA 1
#endif
#ifndef FAST_GEMM
#define FAST_GEMM 1
#endif
#if FAST_GEMM
#define RUN_GEMM(EPI, g, S, E, ALIGN) pg8::gemm_phase<EPI, pg8::StaticOrder, ALIGN, true>(F.lds + RING_OFF, g, S, E)
#else
#define RUN_GEMM(EPI, g, S, E, ALIGN) pg8::gemm_ref<EPI, pg8::StaticOrder>(g, S, E)
#endif

__global__ void __launch_bounds__(NWAVES * 64, 2) fwd_kernel(Args args) {
    extern __shared__ __attribute__((aligned(16))) unsigned char lds[];
    Frame F;
    F.lds = (LAS unsigned char*)lds;
    F.MISC = (volatile LAS unsigned*)(F.lds + MISC_OFF);
    F.tid = threadIdx.x; F.lane = F.tid & 63; F.wave = __builtin_amdgcn_readfirstlane(F.tid >> 6);
    F.G = gridDim.x; { const int bx = blockIdx.x; F.vcu = (F.G % 8 == 0) ? (bx % 8) * (F.G / 8) + bx / 8 : bx; }
    unsigned char* ws = args.ws;
    F.ctl = (gu32*)(ws + WS_CTL);
    F.ws = ws; F.out = args.out;

    for (int u = F.tid; u < (LDS_BYTES - LDSCTL_OFF) / 4; u += NWAVES * 64) ((LAS unsigned*)(F.lds + LDSCTL_OFF))[u] = 0u;
    __syncthreads();
    XcdBarrier bar = xcd_barrier_post((unsigned*)(F.ctl + CW_BAR), F.MISC + 8);
#define GRID_BAR() xcd_barrier(bar)
    const int cid = (int)blockIdx.x;

    F.tid = opaque_tid(); F.lane = F.tid & 63; F.wave = __builtin_amdgcn_readfirstlane(F.tid >> 6);
    p0_prologue(F, args);
    GRID_BAR();
    if (STOP_AFTER < 1) return;
    F.tid = opaque_tid(); F.lane = F.tid & 63; F.wave = __builtin_amdgcn_readfirstlane(F.tid >> 6);
    { pg8::Gemm g{WSP(bf16_t, WS_HB), WSP(bf16_t, WS_W13A), M, 2 * FF, D, D, D}; pg8::StaticOrder S; S.init(M, 2 * FF, F.G, cid); pg8::EpiSwiGLU E{WSP(bf16_t, WS_G), FF}; RUN_GEMM(pg8::EpiSwiGLU, g, S, E, true); }
    GRID_BAR();
    if (STOP_AFTER < 2) return;
    F.tid = opaque_tid(); F.lane = F.tid & 63; F.wave = __builtin_amdgcn_readfirstlane(F.tid >> 6);
    { pg8::Gemm g{WSP(bf16_t, WS_G), WSP(bf16_t, WS_W2A), M, D, FF, FF, FF}; pg8::StaticOrder S; S.init(M, D, F.G, cid); pg8::EpiResid E{INF(0), F.out, D, ALPHA, 0.5f}; RUN_GEMM(pg8::EpiResid, g, S, E, false); }
    GRID_BAR();
    if (STOP_AFTER < 3) return;
    F.tid = opaque_tid(); F.lane = F.tid & 63; F.wave = __builtin_amdgcn_readfirstlane(F.tid >> 6);
    ln_pass(F, F.out, INF(4), INF(5), WSP(bf16_t, WS_HB));
    GRID_BAR();
    if (STOP_AFTER < 4) return;
    F.tid = opaque_tid(); F.lane = F.tid & 63; F.wave = __builtin_amdgcn_readfirstlane(F.tid >> 6);
    { pg8::Gemm g{WSP(bf16_t, WS_HB), WSP(bf16_t, WS_WIN), M, ZLD, D, D, D}; pg8::StaticOrder S; S.init(M, ZLD, F.G, cid); pg8::EpiZ E{WSP(bf16_t, WS_Z), WSP(float, WS_SSQ), WSP(bf16_t, WS_KR), WSP(float, WS_COS), WSP(float, WS_SIN)}; RUN_GEMM(pg8::EpiZ, g, S, E, true); }
    GRID_BAR();
    if (STOP_AFTER < 5) return;
    F.tid = opaque_tid(); F.lane = F.tid & 63; F.wave = __builtin_amdgcn_readfirstlane(F.tid >> 6);
    { pg8::Gemm g{WSP(bf16_t, WS_Z) + Z_CQ, WSP(bf16_t, WS_WUQ), M, QLD, QLORA, ZLD, QLORA}; pg8::StaticOrder S; S.init(M, QLD, F.G, cid); pg8::EpiQ E{WSP(bf16_t, WS_Q), WSP(float, WS_SSQ), WSP(float, WS_COS), WSP(float, WS_SIN), MLA_QSCALE}; RUN_GEMM(pg8::EpiQ, g, S, E, true); }
    { pg8::Gemm g{WSP(bf16_t, WS_Z) + Z_CKV, WSP(bf16_t, WS_WUKV), M, 2 * KLD, KVLORA, ZLD, KVLORA}; pg8::StaticOrder S; S.init(M, 2 * KLD, F.G, cid); pg8::EpiKV E{WSP(bf16_t, WS_K), WSP(bf16_t, WS_V), WSP(float, WS_SSQ)}; RUN_GEMM(pg8::EpiKV, g, S, E, true); }
    GRID_BAR();
    if (STOP_AFTER < 6) return;
    F.tid = opaque_tid(); F.lane = F.tid & 63; F.wave = __builtin_amdgcn_readfirstlane(F.tid >> 6);
#if FAST_MLA
    mla_attn_phase(F);
#else
    mla_attn_naive(F);
#endif
#if FAST_SWA
    swa_attn_phase(F, args);
#else
    swa_attn_naive(F, args);
#endif
    GRID_BAR();
    if (STOP_AFTER < 7) return;
    F.tid = opaque_tid(); F.lane = F.tid & 63; F.wave = __builtin_amdgcn_readfirstlane(F.tid >> 6);
    norm_mix_pass(F);
    GRID_BAR();
    if (STOP_AFTER < 8) return;
    F.tid = opaque_tid(); F.lane = F.tid & 63; F.wave = __builtin_amdgcn_readfirstlane(F.tid >> 6);
    { pg8::Gemm g{WSP(bf16_t, WS_AMIX), WSP(bf16_t, WS_WOUT), M, D, D, D, D}; pg8::StaticOrder S; S.init(M, D, F.G, cid); pg8::EpiResid E{F.out, F.out, D, ALPHA, 1.0f}; RUN_GEMM(pg8::EpiResid, g, S, E, false); }
    GRID_BAR();
    if (STOP_AFTER < 9) return;
    F.tid = opaque_tid(); F.lane = F.tid & 63; F.wave = __builtin_amdgcn_readfirstlane(F.tid >> 6);
    ln_pass(F, F.out, INF(18), INF(19), WSP(bf16_t, WS_HB));
    GRID_BAR();
    if (STOP_AFTER < 10) return;
    F.tid = opaque_tid(); F.lane = F.tid & 63; F.wave = __builtin_amdgcn_readfirstlane(F.tid >> 6);
    { pg8::Gemm g{WSP(bf16_t, WS_HB), WSP(bf16_t, WS_W13B), M, 2 * FF, D, D, D}; pg8::StaticOrder S; S.init(M, 2 * FF, F.G, cid); pg8::EpiSwiGLU E{WSP(bf16_t, WS_G), FF}; RUN_GEMM(pg8::EpiSwiGLU, g, S, E, true); }
    GRID_BAR();
    if (STOP_AFTER < 11) return;
    F.tid = opaque_tid(); F.lane = F.tid & 63; F.wave = __builtin_amdgcn_readfirstlane(F.tid >> 6);
    { pg8::Gemm g{WSP(bf16_t, WS_G), WSP(bf16_t, WS_W2B), M, D, FF, FF, FF}; pg8::StaticOrder S; S.init(M, D, F.G, cid); pg8::EpiResid E{F.out, F.out, D, ALPHA, 0.5f}; RUN_GEMM(pg8::EpiResid, g, S, E, false); }
    GRID_BAR();
    if (STOP_AFTER < 12) return;
    F.tid = opaque_tid(); F.lane = F.tid & 63; F.wave = __builtin_amdgcn_readfirstlane(F.tid >> 6);
    ln_pass(F, F.out, INF(23), INF(24), WSP(bf16_t, WS_HB));
    GRID_BAR();
    if (STOP_AFTER < 13) return;
    F.tid = opaque_tid(); F.lane = F.tid & 63; F.wave = __builtin_amdgcn_readfirstlane(F.tid >> 6);
    { pg8::Gemm g{WSP(bf16_t, WS_PB), WSP(bf16_t, WS_WPLE), M, D, PLE, PLE, PLE}; pg8::StaticOrder S; S.init(M, D, F.G, cid); pg8::EpiBf16 E{WSP(bf16_t, WS_PL), D}; RUN_GEMM(pg8::EpiBf16, g, S, E, false); }
    { pg8::Gemm g{WSP(bf16_t, WS_HB), WSP(bf16_t, WS_WG), M, D, D, D, D}; pg8::StaticOrder S; S.init(M, D, F.G, cid); pg8::EpiGate E{F.out, WSP(bf16_t, WS_PL), D}; RUN_GEMM(pg8::EpiGate, g, S, E, false); }
}

extern "C" void kernel_launch(void* const* d_in, const int* in_sizes, int n_in, void* d_out, int out_size, void* d_ws, size_t ws_size, hipStream_t stream) {
    static int grid = 0;
    if (grid == 0) {
        if (n_in != 27 || in_sizes[0] != M * D || out_size != M * D || ws_size < WS_END) { fprintf(stderr, "kernel_launch: unexpected shapes / workspace (n_in %d, in0 %d, out %d, ws %zu, need %zu); nothing launched\n", n_in, n_in > 0 ? in_sizes[0] : -1, out_size, ws_size, (size_t)WS_END); grid = -1; return; }
        int dev = 0, cus = 0;
        if (hipGetDevice(&dev) != hipSuccess || hipDeviceGetAttribute(&cus, hipDeviceAttributeMultiprocessorCount, dev) != hipSuccess) { grid = -1; return; }
        if (hipFuncSetAttribute((const void*)fwd_kernel, hipFuncAttributeMaxDynamicSharedMemorySize, LDS_BYTES) != hipSuccess) { fprintf(stderr, "kernel_launch: hipFuncSetAttribute failed\n"); grid = -1; return; }
        int per_cu = 0;
        if (hipOccupancyMaxActiveBlocksPerMultiprocessor(&per_cu, (const void*)fwd_kernel, NWAVES * 64, LDS_BYTES) != hipSuccess || per_cu < 1) fprintf(stderr, "kernel_launch: occupancy query reports %d\n", per_cu);
        (void)hipGetLastError();
        grid = cus;
    }
    if (grid < 0) return;
    if (hipMemsetAsync((char*)d_ws + WS_CTL, 0, CTL_ZERO_BYTES, stream) != hipSuccess) return;
    Args a{};
    for (int i = 0; i < 27; ++i) a.in[i] = d_in[i];
    a.out = (float*)d_out; a.ws = (unsigned char*)d_ws;
    hipLaunchKernelGGL(fwd_kernel, dim3(grid), dim3(NWAVES * 64), LDS_BYTES, stream, a);
}
```
